# Optimizing an MI355X kernel written in HIP

```python
import math
import jax, jax.numpy as jnp
from jax import lax
import numpy as np

D_MODEL = 1024
BATCH = 4
SEQ = 4096
DEPTH = 1

DA_HEADS = 4
DA_QK_DIM = 64
DA_V_DIM = 2 * DA_QK_DIM
DA_WIDTH = DA_HEADS * DA_V_DIM
HG_HEADS = 4
HG_DK = 128
HG_DV = 128
HG_WIDTH = HG_HEADS * HG_DV
MIX_WIDTH = DA_WIDTH + HG_WIDTH
DA_Q_COLS = DA_HEADS * 2 * DA_QK_DIM
DA_K_COLS = DA_HEADS * 2 * DA_QK_DIM
DA_V_COLS = DA_WIDTH
HG_Q_COLS = HG_HEADS * HG_DK
HG_F_COLS = HG_HEADS * HG_DK
HG_I_COLS = HG_WIDTH
HG_G_COLS = HG_WIDTH
IN_WIDTH = DA_Q_COLS + DA_K_COLS + DA_V_COLS + HG_Q_COLS + HG_F_COLS + HG_I_COLS + HG_G_COLS
IN_SPLITS = (DA_Q_COLS,
             DA_Q_COLS + DA_K_COLS,
             DA_Q_COLS + DA_K_COLS + DA_V_COLS,
             DA_Q_COLS + DA_K_COLS + DA_V_COLS + HG_Q_COLS,
             DA_Q_COLS + DA_K_COLS + DA_V_COLS + HG_Q_COLS + HG_F_COLS,
             DA_Q_COLS + DA_K_COLS + DA_V_COLS + HG_Q_COLS + HG_F_COLS + HG_I_COLS)
ROPE_THETA = 500000.0
ROT_DIM = DA_QK_DIM // 4
Q_BLOCK = 128
HG_CHUNK = 64
N_GROUPS = 4
EXPERTS_PER_GROUP = 8
N_EXPERTS = N_GROUPS * EXPERTS_PER_GROUP
TOP_K = 2
EXPERT_FF = 256
MOE_BLOCK = 128
EPS = 1e-6

kernel_name = "hymba_diffattn_hgrn2_hmoe_adaln"


def rmsnorm(x, w):
    xf = x.astype(jnp.float32)
    y = xf * lax.rsqrt(jnp.mean(xf * xf, axis=-1, keepdims=True) + EPS)
    return (y * w.astype(jnp.float32)).astype(x.dtype)


def rope_partial(t, positions):
    half = ROT_DIM // 2
    inv_freq = ROPE_THETA ** (-jnp.arange(half, dtype=jnp.float32) / half)
    ang = positions.astype(jnp.float32)[..., None] * inv_freq
    cos = jnp.cos(ang)[:, :, None, :]
    sin = jnp.sin(ang)[:, :, None, :]
    tr = t[..., :ROT_DIM].astype(jnp.float32)
    t1, t2 = tr[..., :half], tr[..., half:]
    rot = jnp.concatenate([t1 * cos - t2 * sin, t2 * cos + t1 * sin], axis=-1).astype(t.dtype)
    return jnp.concatenate([rot, t[..., ROT_DIM:]], axis=-1)


def diff_attention(q, k, v, lam_q1, lam_k1, lam_q2, lam_k2, subln_w, layer_idx):
    B, S, H, _, Dk = q.shape
    lam_init = 0.8 - 0.6 * math.exp(-0.3 * layer_idx)
    lam = (jnp.exp(jnp.sum(lam_q1.astype(jnp.float32) * lam_k1.astype(jnp.float32)))
           - jnp.exp(jnp.sum(lam_q2.astype(jnp.float32) * lam_k2.astype(jnp.float32)))
           + lam_init)
    scale = Dk ** -0.5
    nb = S // Q_BLOCK
    q_blocks = q.reshape(B, nb, Q_BLOCK, H, 2, Dk).transpose(1, 0, 2, 3, 4, 5)
    key_idx = jnp.arange(S)

    def one_block(args):
        qb, bi = args
        s = jnp.einsum('bqhmd,bkhmd->bhmqk', qb, k,
                       preferred_element_type=jnp.float32) * scale
        q_idx = bi * Q_BLOCK + jnp.arange(Q_BLOCK)
        causal = key_idx[None, :] <= q_idx[:, None]
        p = jax.nn.softmax(jnp.where(causal, s, -jnp.inf), axis=-1)
        a = p[:, :, 0] - lam * p[:, :, 1]
        return jnp.einsum('bhqk,bkhd->bqhd', a.astype(v.dtype), v)

    out = lax.map(one_block, (q_blocks, jnp.arange(nb)))
    out = out.transpose(1, 0, 2, 3, 4).reshape(B, S, H, v.shape[-1])
    return rmsnorm(out, subln_w) * (1.0 - lam_init)


def hgrn2_chunkwise(q, f_raw, i, g, lb, norm_w):
    B, S, H, DK = q.shape
    DV = i.shape[-1]
    nc = S // HG_CHUNK
    f32 = jnp.float32
    qf = jax.nn.silu(q.astype(f32))
    f = lb + (1.0 - lb) * jax.nn.sigmoid(f_raw.astype(f32))
    log_f = jnp.log(f)
    kf = 1.0 - f

    def to_chunks(t):
        return t.reshape(B, nc, HG_CHUNK, H, t.shape[-1]).transpose(1, 0, 3, 2, 4)

    tri = jnp.arange(HG_CHUNK)[:, None] >= jnp.arange(HG_CHUNK)[None, :]

    def step(state, inp):
        qc, kc, vc, lfc = inp
        b = jnp.cumsum(lfc, axis=2)
        b_last = b[:, :, -1:, :]
        o_inter = jnp.einsum('bhtk,bhkv->bhtv', qc * jnp.exp(b), state)
        rel = jnp.where(tri[:, :, None], b[:, :, :, None, :] - b[:, :, None, :, :], -jnp.inf)
        scores = jnp.einsum('bhtk,bhsk,bhtsk->bhts', qc, kc, jnp.exp(rel))
        o = o_inter + jnp.einsum('bhts,bhsv->bhtv', scores, vc)
        state = (jnp.exp(b_last[:, :, 0, :])[..., None] * state
                 + jnp.einsum('bhsk,bhsv->bhkv', kc * jnp.exp(b_last - b), vc))
        return state, o

    s0 = jnp.zeros((B, H, DK, DV), f32)
    _, o = lax.scan(step, s0, (to_chunks(qf), to_chunks(kf), to_chunks(i.astype(f32)), to_chunks(log_f)))
    o = o.transpose(1, 0, 3, 2, 4).reshape(B, S, H, DV)
    o = rmsnorm(o, norm_w) * jax.nn.silu(g.astype(f32))
    return o.astype(q.dtype)


def hier_moe(h, w_group, b_group, w_router, b_router, w_gate, w_up, w_down):
    B, S, D = h.shape
    T = B * S
    t = h.reshape(T, D)
    g_logits = jnp.einsum('td,dg->tg', t, w_group, preferred_element_type=jnp.float32) + b_group
    g_prob = jax.nn.softmax(g_logits, axis=-1)
    g_idx = jnp.argmax(g_logits, axis=-1)
    g_w = jnp.take_along_axis(g_prob, g_idx[:, None], axis=1)[:, 0]
    e_logits = (jnp.einsum('td,de->te', t, w_router, preferred_element_type=jnp.float32)
                + b_router).reshape(T, N_GROUPS, EXPERTS_PER_GROUP)
    e_logits = jnp.take_along_axis(e_logits, g_idx[:, None, None], axis=1)[:, 0]
    e_prob = jax.nn.softmax(e_logits, axis=-1)
    top_p, top_i = lax.top_k(e_prob, TOP_K)
    top_p = top_p / jnp.sum(top_p, axis=-1, keepdims=True)
    expert_ids = g_idx[:, None] * EXPERTS_PER_GROUP + top_i
    weights = top_p * g_w[:, None]
    combine = jnp.sum(jax.nn.one_hot(expert_ids, N_EXPERTS, dtype=jnp.float32)
                      * weights[..., None], axis=1)

    nb = T // MOE_BLOCK

    def one_block(args):
        tb, cb = args
        hg = jnp.einsum('td,edf->tef', tb, w_gate)
        hu = jnp.einsum('td,edf->tef', tb, w_up)
        act = jax.nn.silu(hg) * hu * cb[..., None].astype(tb.dtype)
        return jnp.einsum('tef,efd->td', act, w_down)

    y = lax.map(one_block, (t.reshape(nb, MOE_BLOCK, D), combine.reshape(nb, MOE_BLOCK, N_EXPERTS)))
    return y.reshape(B, S, D)


def setup_inputs(seed: int = 0) -> dict:
    key = jax.random.key(seed)
    ks = jax.random.split(key, 24)
    f32 = jnp.float32
    nrm = lambda k, shape, s: jax.random.normal(k, shape, f32) * s
    return {
        "x": nrm(ks[0], (BATCH, SEQ, D_MODEL), 1.0),
        "c": nrm(ks[1], (BATCH, D_MODEL), 1.0),
        "positions": jnp.broadcast_to(jnp.arange(SEQ, dtype=jnp.int32), (BATCH, SEQ)),
        "norm1_w": 1.0 + nrm(ks[2], (DEPTH, D_MODEL), 0.02),
        "norm2_w": 1.0 + nrm(ks[3], (DEPTH, D_MODEL), 0.02),
        "final_norm_w": 1.0 + nrm(ks[4], (D_MODEL,), 0.02),
        "ada_w": nrm(ks[5], (DEPTH, D_MODEL, 6 * D_MODEL), 0.5 * D_MODEL ** -0.5),
        "ada_b": nrm(ks[6], (DEPTH, 6 * D_MODEL), 0.02),
        "w_in": nrm(ks[7], (DEPTH, D_MODEL, IN_WIDTH), D_MODEL ** -0.5),
        "w_out": nrm(ks[8], (DEPTH, MIX_WIDTH, D_MODEL), MIX_WIDTH ** -0.5),
        "da_lambda_q1": nrm(ks[9], (DEPTH, DA_QK_DIM), 0.1),
        "da_lambda_k1": nrm(ks[10], (DEPTH, DA_QK_DIM), 0.1),
        "da_lambda_q2": nrm(ks[11], (DEPTH, DA_QK_DIM), 0.1),
        "da_lambda_k2": nrm(ks[12], (DEPTH, DA_QK_DIM), 0.1),
        "da_subln_w": 1.0 + nrm(ks[13], (DEPTH, DA_V_DIM), 0.02),
        "hg_lower_bound": nrm(ks[14], (DEPTH + 1, HG_HEADS * HG_DK), 0.1),
        "hg_norm_w": 1.0 + nrm(ks[15], (DEPTH, HG_DV), 0.02),
        "moe_w_group": nrm(ks[16], (DEPTH, D_MODEL, N_GROUPS), D_MODEL ** -0.5),
        "moe_b_group": nrm(ks[17], (DEPTH, N_GROUPS), 0.01),
        "moe_w_router": nrm(ks[18], (DEPTH, D_MODEL, N_EXPERTS), D_MODEL ** -0.5),
        "moe_b_router": nrm(ks[19], (DEPTH, N_EXPERTS), 0.01),
        "moe_w_gate": nrm(ks[20], (DEPTH, N_EXPERTS, D_MODEL, EXPERT_FF), D_MODEL ** -0.5),
        "moe_w_up": nrm(ks[21], (DEPTH, N_EXPERTS, D_MODEL, EXPERT_FF), D_MODEL ** -0.5),
        "moe_w_down": nrm(ks[22], (DEPTH, N_EXPERTS, EXPERT_FF, D_MODEL), EXPERT_FF ** -0.5),
    }


def reference(x, c, positions, norm1_w, norm2_w, final_norm_w, ada_w, ada_b, w_in, w_out,
              da_lambda_q1, da_lambda_k1, da_lambda_q2, da_lambda_k2, da_subln_w,
              hg_lower_bound, hg_norm_w, moe_w_group, moe_b_group, moe_w_router, moe_b_router,
              moe_w_gate, moe_w_up, moe_w_down):
    B, S, D = x.shape
    lower_bounds = jnp.cumsum(jax.nn.softmax(hg_lower_bound.astype(jnp.float32), axis=0), axis=0)
    c_act = jax.nn.silu(c)
    for l in range(DEPTH):
        mod = jnp.einsum('bd,de->be', c_act, ada_w[l]) + ada_b[l]
        shift1, scale1, gate1, shift2, scale2, gate2 = jnp.split(mod, 6, axis=-1)

        h = rmsnorm(x, norm1_w[l]) * (1.0 + scale1[:, None]) + shift1[:, None]
        proj = jnp.einsum('bsd,de->bse', h, w_in[l])
        dq, dk, dv, gq, gf, gi, gg = jnp.split(proj, IN_SPLITS, axis=-1)
        dq = rope_partial(dq.reshape(B, S, DA_HEADS * 2, DA_QK_DIM), positions)
        dk = rope_partial(dk.reshape(B, S, DA_HEADS * 2, DA_QK_DIM), positions)
        da_out = diff_attention(dq.reshape(B, S, DA_HEADS, 2, DA_QK_DIM),
                                dk.reshape(B, S, DA_HEADS, 2, DA_QK_DIM),
                                dv.reshape(B, S, DA_HEADS, DA_V_DIM),
                                da_lambda_q1[l], da_lambda_k1[l], da_lambda_q2[l], da_lambda_k2[l],
                                da_subln_w[l], l)
        hg_out = hgrn2_chunkwise(gq.reshape(B, S, HG_HEADS, HG_DK),
                                 gf.reshape(B, S, HG_HEADS, HG_DK),
                                 gi.reshape(B, S, HG_HEADS, HG_DV),
                                 gg.reshape(B, S, HG_HEADS, HG_DV),
                                 lower_bounds[l].reshape(HG_HEADS, HG_DK), hg_norm_w[l])
        mixed = jnp.concatenate([da_out.reshape(B, S, DA_WIDTH).astype(x.dtype),
                                 hg_out.reshape(B, S, HG_WIDTH).astype(x.dtype)], axis=-1)
        x = x + gate1[:, None] * jnp.einsum('bse,ed->bsd', mixed, w_out[l])

        h2 = rmsnorm(x, norm2_w[l]) * (1.0 + scale2[:, None]) + shift2[:, None]
        y = hier_moe(h2, moe_w_group[l], moe_b_group[l], moe_w_router[l], moe_b_router[l],
                     moe_w_gate[l], moe_w_up[l], moe_w_down[l])
        x = x + gate2[:, None] * y
    return rmsnorm(x, final_norm_w)
```

```cpp
#include <hip/hip_runtime.h>
#include <hip/hip_cooperative_groups.h>
#include <cstdio>
#include <cstdint>
#include <cmath>
namespace cg = cooperative_groups;

namespace pg8 {
#define PG8_LAS __attribute__((address_space(3)))
typedef unsigned short bf16_t;
typedef short bf16x8 __attribute__((ext_vector_type(8)));
typedef float f32x4 __attribute__((ext_vector_type(4)));
typedef unsigned u32x4 __attribute__((ext_vector_type(4)));
constexpr int BM = 256, BK = 64, HALF = 128, HTB = HALF * BK * 2  , STAGE_BYTES = 8 * HTB, NXCD = 8, WGM = 8;

__host__ __device__ __forceinline__ int lds_byte(int r, int c) { const int st = (r >> 4) * 2 + (c >> 5), rr = r & 15, cc = c & 31, ob = rr * 64 + cc * 2; return st * 1024 + (ob ^ (((ob >> 9) & 1) << 5)); }
__host__ __device__ __forceinline__ void stage_rc(int b, int& R, int& C) { const int st = b / 1024, sb = b % 1024, swz = sb ^ (((sb >> 9) & 1) << 5); R = (st >> 1) * 16 + swz / 64; C = (st & 1) * 32 + (swz % 64) / 2; }
__host__ __device__ __forceinline__ int perm32(int rho) { const int n = rho >> 4, i = rho & 15; return 8 * (i >> 2) + 4 * n + (i & 3); }

struct Unit { int pm, pn; };
struct Gemm { const bf16_t* A; const bf16_t* Bt; int M, N, K; };

struct StaticOrder {
    int nM, nN, nwg, G, c;
    __host__ __device__ void init(int M, int N, int G_, int c_) { nM = M / BM; nN = N / BM; nwg = nM * nN; G = G_; c = c_; }
    __host__ __device__ bool next(int i, Unit& u) const {
        const long L = (long)i * G + c; if (L >= nwg) return false;
        int wgid = (int)L; { const int q = nwg / NXCD, r = nwg % NXCD, xcd = wgid % NXCD, off = wgid / NXCD; wgid = (xcd < r ? xcd * (q + 1) : r * (q + 1) + (xcd - r) * q) + off; }
        const int nig = WGM * nN, gid = wgid / nig, fm = gid * WGM, gsz = (nM - fm) < WGM ? (nM - fm) : WGM;
        u.pm = fm + ((wgid % nig) % gsz); u.pn = (wgid % nig) / gsz; return true;
    }
    __device__ __forceinline__ void a_ready(const Unit&) const {}
    __device__ __forceinline__ void done(const Unit&) const {}
};


__device__ __forceinline__ unsigned cvt_pk_bf16(float lo, float hi) { unsigned r; asm volatile("v_cvt_pk_bf16_f32 %0, %1, %2" : "=v"(r) : "v"(lo), "v"(hi)); return r; }
typedef float f32x2 __attribute__((ext_vector_type(2)));

template <class Epi, class Sched, bool ALIGN_EPI = false, bool SP2 = false>
__device__ __forceinline__ void gemm_phase(PG8_LAS unsigned char* lds, const Gemm g, const Sched& S, const Epi& E) {
    const int tid = threadIdx.x, wid = __builtin_amdgcn_readfirstlane(tid >> 6), lane = tid & 63, wr = wid >> 2, wc = wid & 3, fr = lane & 15, fq = lane >> 4;
    const int K = g.K, nt = K / BK;
    unsigned voffA[2], voffB[2];
#pragma unroll
    for (int i = 0; i < 2; ++i) { int R, C; stage_rc(tid * 16 + i * 8192, R, C); const int Rb = Epi::PERM ? ((R & ~31) + perm32(R & 31)) : R;
        voffA[i] = (unsigned)(R * K + C) * 2u; voffB[i] = (unsigned)(Rb * K + C) * 2u; }
    const size_t kstep = (size_t)(BK * 2);
    const size_t hstep = (size_t)HALF * K * 2;
    const size_t tstep = 2 * hstep;
    const unsigned ldsw = (unsigned)wid * 1024u;
    const int aoff = lds_byte(wr * 64 + fr, fq * 8), boff = lds_byte(wc * 32 + fr, fq * 8);
#define PG8_SA(b, h) (((b) * 2 + (h)) * HTB)
#define PG8_SB(b, h) ((4 + (b) * 2 + (h)) * HTB)
#define PG8_STAGE(bufoff, gbase, voff) do { _Pragma("unroll") for (int _i = 0; _i < 2; ++_i) \
        __builtin_amdgcn_global_load_lds((const unsigned*)((const char*)(gbase) + (voff)[_i]), (PG8_LAS unsigned*)(lds + (bufoff) + ldsw + _i * 8192), 16, 0, 0); } while (0)
#define PG8_LDA(dst, b, h) do { _Pragma("unroll") for (int m = 0; m < 4; ++m) _Pragma("unroll") for (int k = 0; k < 2; ++k) dst[m][k] = *(const PG8_LAS bf16x8*)(lds + PG8_SA(b, h) + aoff + m * 2048 + k * 1024); } while (0)
#define PG8_LDB(dst, b, h) do { _Pragma("unroll") for (int n = 0; n < 2; ++n) _Pragma("unroll") for (int k = 0; k < 2; ++k) dst[n][k] = *(const PG8_LAS bf16x8*)(lds + PG8_SB(b, h) + boff + n * 2048 + k * 1024); } while (0)
#define PG8_MMA(ai, bj, At, Bt) do { __builtin_amdgcn_s_setprio(1); _Pragma("unroll") for (int m = 0; m < 4; ++m) _Pragma("unroll") for (int n = 0; n < 2; ++n) _Pragma("unroll") for (int k = 0; k < 2; ++k) \
        acc[ai][bj][m][n] = __builtin_amdgcn_mfma_f32_16x16x32_bf16(Bt[n][k], At[m][k], acc[ai][bj][m][n], 0, 0, 0); __builtin_amdgcn_s_setprio(0); } while (0)
#define PG8_WAIT_V(n) asm volatile("s_waitcnt vmcnt(" #n ")" ::: "memory")
#define PG8_WAIT_L(n) asm volatile("s_waitcnt lgkmcnt(" #n ")" ::: "memory")
#define PG8_BAR __builtin_amdgcn_s_barrier()
#define PG8_SCHED __builtin_amdgcn_sched_barrier(0)
    Unit cur, nxt; int ui = 0;
    if (!S.next(0, cur)) return;
    f32x4 acc[2][2][4][2];
#pragma unroll
    for (int a = 0; a < 2; ++a)
#pragma unroll
        for (int b = 0; b < 2; ++b)
#pragma unroll
            for (int m = 0; m < 4; ++m)
#pragma unroll
                for (int n = 0; n < 2; ++n) acc[a][b][m][n] = (f32x4){0.f, 0.f, 0.f, 0.f};
    bf16x8 At[4][2], B0[2][2], B1[2][2];
    const char* cA = (const char*)g.A + (size_t)cur.pm * tstep; const char* cB = (const char*)g.Bt + (size_t)cur.pn * tstep;
    S.a_ready(cur);
    if constexpr (SP2) {
        PG8_STAGE(PG8_SB(0, 0), cB, voffB); PG8_STAGE(PG8_SB(0, 1), cB + hstep, voffB); PG8_STAGE(PG8_SA(0, 0), cA, voffA); PG8_STAGE(PG8_SA(0, 1), cA + hstep, voffA);
        if (wr == 1) PG8_BAR;
        PG8_WAIT_V(2); PG8_BAR;
        PG8_STAGE(PG8_SB(1, 0), cB + kstep, voffB); PG8_STAGE(PG8_SA(1, 0), cA + kstep, voffA); PG8_STAGE(PG8_SB(1, 1), cB + hstep + kstep, voffB);
        PG8_WAIT_V(6); PG8_BAR;
    } else {
        PG8_STAGE(PG8_SB(0, 0), cB, voffB); PG8_STAGE(PG8_SA(0, 0), cA, voffA); PG8_STAGE(PG8_SB(0, 1), cB + hstep, voffB); PG8_STAGE(PG8_SA(0, 1), cA + hstep, voffA);
        if (wr == 1) PG8_BAR;
        PG8_WAIT_V(4); PG8_BAR;
        PG8_STAGE(PG8_SB(1, 0), cB + kstep, voffB); PG8_STAGE(PG8_SA(1, 0), cA + kstep, voffA); PG8_STAGE(PG8_SB(1, 1), cB + hstep + kstep, voffB);
        PG8_WAIT_V(6); PG8_BAR;
    }
    for (;;) {
        const bool has_next = S.next(ui + 1, nxt);
        const char* nA = has_next ? (const char*)g.A + (size_t)nxt.pm * tstep : cA; const char* nB = has_next ? (const char*)g.Bt + (size_t)nxt.pn * tstep : cB;
        for (int t = 0; t < nt; t += 2) {
            const bool last = (t == nt - 2);
            const char* a1 = cA + (size_t)(t + 1) * kstep;
            const char* a2 = last ? nA : cA + (size_t)(t + 2) * kstep; const char* b2 = last ? nB : cB + (size_t)(t + 2) * kstep;
            const char* a3 = a2 + kstep; const char* b3 = b2 + kstep;
            if (last && has_next) S.a_ready(nxt);
            if constexpr (SP2) {
            PG8_LDB(B0, 0, 0); PG8_LDB(B1, 0, 1); PG8_SCHED; PG8_LDA(At, 0, 0); PG8_STAGE(PG8_SA(1, 1), a1 + hstep, voffA);
            PG8_WAIT_V(8); PG8_WAIT_L(0); PG8_BAR; PG8_MMA(0, 0, At, B0); PG8_MMA(0, 1, At, B1); PG8_BAR; PG8_SCHED;
            PG8_LDA(At, 0, 1); PG8_STAGE(PG8_SB(0, 0), b2, voffB); PG8_STAGE(PG8_SB(0, 1), b2 + hstep, voffB); PG8_STAGE(PG8_SA(0, 0), a2, voffA);
            PG8_WAIT_V(8); PG8_WAIT_L(0); PG8_BAR; PG8_MMA(1, 0, At, B0); PG8_MMA(1, 1, At, B1); PG8_BAR; PG8_SCHED;
            PG8_LDB(B0, 1, 0); PG8_LDB(B1, 1, 1); PG8_SCHED; PG8_LDA(At, 1, 0); PG8_STAGE(PG8_SA(0, 1), a2 + hstep, voffA);
            PG8_WAIT_V(8); PG8_WAIT_L(0); PG8_BAR; PG8_MMA(0, 0, At, B0); PG8_MMA(0, 1, At, B1); PG8_BAR; PG8_SCHED;
            PG8_LDA(At, 1, 1); PG8_STAGE(PG8_SB(1, 0), b3, voffB); PG8_STAGE(PG8_SB(1, 1), b3 + hstep, voffB); PG8_STAGE(PG8_SA(1, 0), a3, voffA);
            PG8_WAIT_V(8); PG8_WAIT_L(0); PG8_BAR; PG8_MMA(1, 0, At, B0); PG8_MMA(1, 1, At, B1); PG8_BAR; PG8_SCHED;
            } else {
            PG8_LDB(B0, 0, 0); PG8_SCHED; PG8_LDA(At, 0, 0); PG8_STAGE(PG8_SA(1, 1), a1 + hstep, voffA);
            PG8_WAIT_L(8); PG8_BAR; PG8_WAIT_L(0); PG8_MMA(0, 0, At, B0); PG8_BAR; PG8_SCHED;
            PG8_LDB(B1, 0, 1); PG8_STAGE(PG8_SB(0, 0), b2, voffB);
            PG8_BAR; PG8_WAIT_L(0); PG8_MMA(0, 1, At, B1); PG8_BAR;
            PG8_LDA(At, 0, 1); PG8_STAGE(PG8_SA(0, 0), a2, voffA);
            PG8_BAR; PG8_WAIT_L(0); PG8_MMA(1, 0, At, B0); PG8_BAR; PG8_SCHED;
            PG8_STAGE(PG8_SB(0, 1), b2 + hstep, voffB);
            PG8_WAIT_V(6); PG8_BAR; PG8_MMA(1, 1, At, B1); PG8_BAR;
            PG8_LDB(B0, 1, 0); PG8_SCHED; PG8_LDA(At, 1, 0); PG8_STAGE(PG8_SA(0, 1), a2 + hstep, voffA);
            PG8_WAIT_L(8); PG8_BAR; PG8_WAIT_L(0); PG8_MMA(0, 0, At, B0); PG8_BAR; PG8_SCHED;
            PG8_LDB(B1, 1, 1); PG8_STAGE(PG8_SB(1, 0), b3, voffB);
            PG8_BAR; PG8_WAIT_L(0); PG8_MMA(0, 1, At, B1); PG8_BAR;
            PG8_LDA(At, 1, 1); PG8_STAGE(PG8_SA(1, 0), a3, voffA);
            PG8_BAR; PG8_WAIT_L(0); PG8_MMA(1, 0, At, B0); PG8_BAR; PG8_SCHED;
            PG8_STAGE(PG8_SB(1, 1), b3 + hstep, voffB);
            PG8_WAIT_V(6); PG8_BAR; PG8_MMA(1, 1, At, B1); PG8_BAR;
            }
        }
        if constexpr (ALIGN_EPI) { if (wr == 0) PG8_BAR; }
        if constexpr (!Epi::AFTER_DRAIN) { E(acc, cur, wr, wc, fr, fq); S.done(cur); }
        if (!has_next) break;
#pragma unroll
        for (int a = 0; a < 2; ++a)
#pragma unroll
            for (int b = 0; b < 2; ++b)
#pragma unroll
                for (int m = 0; m < 4; ++m)
#pragma unroll
                    for (int n = 0; n < 2; ++n) acc[a][b][m][n] = (f32x4){0.f, 0.f, 0.f, 0.f};
        cur = nxt; cA = nA; cB = nB; ++ui;
        if constexpr (ALIGN_EPI) { if (wr == 1) PG8_BAR; }
    }
    PG8_WAIT_V(0);
    if constexpr (!ALIGN_EPI) { if (wr == 0) PG8_BAR; }
    PG8_BAR;
    if constexpr (Epi::AFTER_DRAIN) { E.fused(acc, cur, wr, wc, fr, fq, lds, wid, lane); S.done(cur); }
#undef PG8_SA
#undef PG8_SB
#undef PG8_STAGE
#undef PG8_LDA
#undef PG8_LDB
#undef PG8_MMA
#undef PG8_WAIT_V
#undef PG8_WAIT_L
#undef PG8_BAR
#undef PG8_SCHED
}
}

#ifndef PHASE_MASK
#define PHASE_MASK 0xFFF
#endif
#ifndef ONE_LAUNCH
#define ONE_LAUNCH 1
#endif
#ifndef FAST_GEMM
#define FAST_GEMM 1
#endif
#ifndef FAST_ATTN
#define FAST_ATTN 1
#endif
#ifndef FAST_HGRN
#define FAST_HGRN 1
#endif

#define GAS __attribute__((address_space(1)))
#define LAS __attribute__((address_space(3)))
typedef unsigned short bf16;
typedef unsigned v4u __attribute__((ext_vector_type(4)));
typedef unsigned v2u __attribute__((ext_vector_type(2)));
typedef float f32x4 __attribute__((ext_vector_type(4)));
typedef float f32x2 __attribute__((ext_vector_type(2)));
typedef float f32x16 __attribute__((ext_vector_type(16)));
typedef short bf16x8 __attribute__((ext_vector_type(8)));
typedef short s16x4 __attribute__((ext_vector_type(4)));
#define LDS_WAIT() asm volatile("s_waitcnt lgkmcnt(0)" ::: "memory")
#define VM_WAIT() asm volatile("s_waitcnt vmcnt(0)" ::: "memory")

constexpr int NB = 4, SEQ = 4096, T = NB * SEQ, DM = 1024, INW = 3584, NE = 32, FF = 256, HW = 512  ;
constexpr int NWAVES = 8, NTHR = 512;
constexpr float EPS = 1e-6f;
constexpr float QSCALE = 0.125f * 1.4426950408889634f;
constexpr int XS_ROWS = 40960;

constexpr size_t MiB = 1u << 20;
constexpr size_t WS_CTL = 0, CTL_ZERO_BYTES = 256 * 1024;
constexpr size_t WS_MOD = 1 * MiB;
constexpr size_t WS_BIAS1 = 1 * MiB + 128 * 1024;
constexpr size_t WS_LB = 1 * MiB + 192 * 1024;
constexpr size_t WS_WRT = 1 * MiB + 256 * 1024;
constexpr size_t WS_TOKE = 2 * MiB;
constexpr size_t WS_TOKW = 2 * MiB + 128 * 1024;
constexpr size_t WS_TOKP = 2 * MiB + 256 * 1024;
constexpr size_t WS_ROWINFO = 2 * MiB + 384 * 1024;
constexpr size_t WS_ROWW = 2 * MiB + 576 * 1024;
constexpr size_t WS_WOT = 4 * MiB;
constexpr size_t WS_WB = 6 * MiB;
constexpr size_t WS_XN = 34 * MiB;
constexpr size_t WS_MIXED = WS_XN;
constexpr size_t WS_Y = 6 * MiB;
constexpr size_t WS_WGU = 70 * MiB;
constexpr size_t WS_WD = 102 * MiB;
constexpr size_t WS_Q = 118 * MiB, WS_K = 134 * MiB, WS_V = 150 * MiB, WS_GQ = 166 * MiB, WS_GI = 182 * MiB, WS_GG = 198 * MiB;
constexpr size_t WS_LF = 214 * MiB;
constexpr size_t WS_H2 = 118 * MiB;
constexpr size_t WS_XS = 150 * MiB;
constexpr size_t WS_HM = 230 * MiB;
constexpr size_t WS_END = 256 * MiB;
static_assert(WS_LF + (size_t)T * HW * 4 <= WS_END && WS_HM + (size_t)XS_ROWS * FF * 2 <= WS_END && WS_XS + (size_t)XS_ROWS * DM * 2 <= WS_HM && WS_Y + (size_t)T * 2 * DM * 2 <= WS_WGU, "ws map");
constexpr size_t DO_U = 0, DO_D = 32 * MiB, DO_ONAIVE = 0;
constexpr int CW_CNT = 1024;
constexpr int CW_BAR = 4096;

constexpr int LDS_BYTES = 147456;
constexpr int LDS_CTL_OFF = 131072;
constexpr int LC_TILE_E = 64;
constexpr int LC_NTILES = 60;

struct Params {
    const float* x; const float* c; const int* positions; const float* norm1_w; const float* norm2_w; const float* final_norm_w;
    const float* ada_w; const float* ada_b; const float* w_in; const float* w_out;
    const float* lq1; const float* lk1; const float* lq2; const float* lk2; const float* subln_w;
    const float* hg_lb; const float* hg_norm_w; const float* w_group; const float* b_group; const float* w_router; const float* b_router;
    const float* w_gate; const float* w_up; const float* w_down;
    float* out; unsigned char* ws; int ph_lo, ph_hi;
};

__device__ __forceinline__ unsigned f2bf(float f) { unsigned u = __builtin_bit_cast(unsigned, f); return (u + 0x7fffu + ((u >> 16) & 1u)) >> 16; }
__device__ __forceinline__ unsigned pk2(float lo, float hi) { return f2bf(lo) | (f2bf(hi) << 16); }
__device__ __forceinline__ float bf2f(unsigned short h) { return __builtin_bit_cast(float, (unsigned)h << 16); }
__device__ __forceinline__ float bflo(unsigned w) { return __builtin_bit_cast(float, w << 16); }
__device__ __forceinline__ float bfhi(unsigned w) { return __builtin_bit_cast(float, w & 0xffff0000u); }
__device__ __forceinline__ float wave_sum(float v) {
#pragma unroll
    for (int o = 1; o < 64; o <<= 1) v += __shfl_xor(v, o);
    return v;
}
__device__ __forceinline__ float wave_max(float v) {
#pragma unroll
    for (int o = 1; o < 64; o <<= 1) v = fmaxf(v, __shfl_xor(v, o));
    return v;
}
__device__ __forceinline__ float silu_f(float v) { return v / (1.f + __expf(-v)); }
__device__ __forceinline__ float sigmoid_f(float v) { return 1.f / (1.f + __expf(-v)); }

__device__ __forceinline__ void tile_load(const float* W, int N, int k0, int n0, LAS float* scr, int lane) {
#pragma unroll 8
    for (int i = 0; i < 32; ++i) { const int kk = 2 * i + (lane >> 5); scr[kk * 33 + (lane & 31)] = W[(size_t)(k0 + kk) * N + n0 + (lane & 31)]; }
    LDS_WAIT(); asm volatile("" ::: "memory");
}
__device__ __forceinline__ void tile_store(const LAS float* scr, bf16* drow0, int K, int k0, int lane, const float* sc) {
    const int c = lane & 7;
#pragma unroll
    for (int j = 0; j < 4; ++j) { const int n = (lane >> 3) + 8 * j; const LAS float* s = scr + (8 * c) * 33 + n;
        v4u o;
        if (sc) { o.x = pk2(s[0 * 33] * sc[0], s[1 * 33] * sc[1]); o.y = pk2(s[2 * 33] * sc[2], s[3 * 33] * sc[3]); o.z = pk2(s[4 * 33] * sc[4], s[5 * 33] * sc[5]); o.w = pk2(s[6 * 33] * sc[6], s[7 * 33] * sc[7]); }
        else { o.x = pk2(s[0 * 33], s[1 * 33]); o.y = pk2(s[2 * 33], s[3 * 33]); o.z = pk2(s[4 * 33], s[5 * 33]); o.w = pk2(s[6 * 33], s[7 * 33]); }
        *(v4u*)(drow0 + (size_t)n * K + k0 + 8 * c) = o; }
}

__device__ __forceinline__ void phase_prep(const Params& P, LAS unsigned char* lds, int vb, int nvb) {
    const int tid = threadIdx.x, lane = tid & 63, wave = tid >> 6;
    unsigned char* ws = P.ws;
    {
        LAS float* cact = (LAS float*)lds;
        LAS float* part = (LAS float*)(lds + 16384);
        bool have = false;
        for (int it = vb; it < 192; it += nvb) {
            if (!have) { for (int i = tid; i < 4096; i += NTHR) cact[i] = silu_f(P.c[i]); have = true; }
            __syncthreads();
            const int cg_ = tid & 7, rg = tid >> 3, e0 = it * 32 + cg_ * 4;
            float acc[4][4];
#pragma unroll
            for (int b = 0; b < 4; ++b)
#pragma unroll
                for (int j = 0; j < 4; ++j) acc[b][j] = 0.f;
#pragma unroll 4
            for (int i = 0; i < 16; ++i) { const int d = rg + 64 * i; const f32x4 w = *(const f32x4*)(P.ada_w + (size_t)d * 6144 + e0);
#pragma unroll
                for (int b = 0; b < 4; ++b) { const float cv = cact[b * 1024 + d]; acc[b][0] += cv * w.x; acc[b][1] += cv * w.y; acc[b][2] += cv * w.z; acc[b][3] += cv * w.w; } }
#pragma unroll
            for (int b = 0; b < 4; ++b)
#pragma unroll
                for (int j = 0; j < 4; ++j) part[(rg * 8 + cg_) * 16 + b * 4 + j] = acc[b][j];
            __syncthreads();
            if (tid < 128) { const int cgi = tid >> 4, bj = tid & 15; float s = 0.f;
                for (int r = 0; r < 64; ++r) s += part[(r * 8 + cgi) * 16 + bj];
                const int b = bj >> 2, e = it * 32 + cgi * 4 + (bj & 3);
                ((float*)(ws + WS_MOD))[b * 6144 + e] = s + P.ada_b[e]; }
            __syncthreads();
        }
    }
    __syncthreads();
    const int gw = vb * NWAVES + wave, NGW = nvb * NWAVES;
    for (int m = gw; m < T; m += NGW) {
        const f32x4* xr = (const f32x4*)(P.x + (size_t)m * DM) + lane;
        f32x4 v[4]; float s = 0.f;
#pragma unroll
        for (int j = 0; j < 4; ++j) { v[j] = xr[64 * j]; s += (v[j].x * v[j].x + v[j].y * v[j].y) + (v[j].z * v[j].z + v[j].w * v[j].w); }
        const float rstd = rsqrtf(wave_sum(s) * (1.f / DM) + EPS);
        unsigned long long* o8 = (unsigned long long*)((bf16*)(ws + WS_XN) + (size_t)m * DM) + lane;
#pragma unroll
        for (int j = 0; j < 4; ++j) o8[64 * j] = (unsigned long long)pk2(v[j].x * rstd, v[j].y * rstd) | ((unsigned long long)pk2(v[j].z * rstd, v[j].w * rstd) << 32);
    }
    {
        LAS float* scr = (LAS float*)(lds + wave * 16384);
        constexpr int I_WO = 16 * 32, I_G = 16 * 8, I_D = 4 * 32;
        constexpr int NIT = I_WO + NE * I_G * 2 + NE * I_D;
        for (int it = gw; it < NIT; it += NGW) {
            int r = it;
            if (r < I_WO) { const int kb = r / 32, nb = r % 32; tile_load(P.w_out, DM, kb * 64, nb * 32, scr, lane);
                tile_store(scr, (bf16*)(ws + WS_WOT) + (size_t)(nb * 32) * DM, DM, kb * 64, lane, nullptr); LDS_WAIT(); asm volatile("" ::: "memory"); continue; }
            r -= I_WO;
            if (r < NE * I_G * 2) { const int gu = r / (NE * I_G), rr = r % (NE * I_G), e = rr / I_G, q = rr % I_G, kb = q / 8, nb = q % 8;
                const float* W = (gu ? P.w_up : P.w_gate) + (size_t)e * DM * FF; const int f0 = nb * 32;
                tile_load(W, FF, kb * 64, f0, scr, lane);
                const int row0 = 256 * (f0 >> 7) + 128 * gu + (f0 & 127);
                tile_store(scr, (bf16*)(ws + WS_WGU) + ((size_t)e * 512 + row0) * DM, DM, kb * 64, lane, nullptr); LDS_WAIT(); asm volatile("" ::: "memory"); continue; }
            r -= NE * I_G * 2;
            { const int e = r / I_D, q = r % I_D, kb = q / 32, nb = q % 32;
                tile_load(P.w_down + (size_t)e * FF * DM, DM, kb * 64, nb * 32, scr, lane);
                tile_store(scr, (bf16*)(ws + WS_WD) + ((size_t)e * DM + nb * 32) * FF, FF, kb * 64, lane, nullptr); LDS_WAIT(); asm volatile("" ::: "memory"); }
        }
    }
    for (int i = vb * NTHR + tid; i < 512 + 36 * 1024; i += nvb * NTHR) {
        if (i < 512) { const float a0 = P.hg_lb[i], a1 = P.hg_lb[512 + i]; ((float*)(ws + WS_LB))[i] = 1.f / (1.f + __expf(a1 - a0)); }
        else { const int q = i - 512, j = q >> 10, d = q & 1023; ((float*)(ws + WS_WRT))[q] = j < 4 ? P.w_group[d * 4 + j] : P.w_router[d * 32 + (j - 4)]; }
    }
}

__device__ __forceinline__ void phase_fold(const Params& P, LAS unsigned char* lds, int vb, int nvb) {
    const int tid = threadIdx.x, lane = tid & 63, wave = tid >> 6;
    unsigned char* ws = P.ws; const float* mod = (const float*)(ws + WS_MOD);
    const int gw = vb * NWAVES + wave, NGW = nvb * NWAVES;
    LAS float* scr = (LAS float*)(lds + wave * 16384);
    for (int it = gw; it < 16 * 112; it += NGW) {
        const int kb = it / 112, nb = it % 112, k0 = kb * 64, n0 = nb * 32;
        tile_load(P.w_in, INW, k0, n0, scr, lane);
        const int c = lane & 7;
#pragma unroll 1
        for (int b = 0; b < 4; ++b) { float sc[8];
#pragma unroll
            for (int j = 0; j < 8; ++j) { const int k = k0 + 8 * c + j; sc[j] = P.norm1_w[k] * (1.f + mod[b * 6144 + 1024 + k]); }
            tile_store(scr, (bf16*)(ws + WS_WB) + ((size_t)b * INW + n0) * DM, DM, k0, lane, sc); }
        LDS_WAIT(); asm volatile("" ::: "memory");
    }
    __syncthreads();
    LAS float* red = (LAS float*)lds;
    for (int it = vb; it < 56; it += nvb) {
        const int n = it * 64 + lane; float a[4] = {0.f, 0.f, 0.f, 0.f};
#pragma unroll 8
        for (int i = 0; i < 128; ++i) { const int k = wave * 128 + i; const float w = P.w_in[(size_t)k * INW + n];
#pragma unroll
            for (int b = 0; b < 4; ++b) a[b] += mod[b * 6144 + k] * w; }
#pragma unroll
        for (int b = 0; b < 4; ++b) red[(wave * 4 + b) * 64 + lane] = a[b];
        __syncthreads();
        if (tid < 256) { const int b = tid >> 6; float s = 0.f;
#pragma unroll
            for (int w8 = 0; w8 < 8; ++w8) s += red[(w8 * 4 + b) * 64 + lane];
            ((float*)(ws + WS_BIAS1))[b * INW + n] = s; }
        __syncthreads();
    }
}

__device__ __forceinline__ void proj_finish(const Params& P, int r, int c0, float* v, const float* pv) {
    unsigned char* ws = P.ws;
    const int b = r >> 12, region = c0 >> 9, cc = c0 & 511;
    const float* bias = (const float*)(ws + WS_BIAS1) + b * INW;
    {   const f32x4 b0 = *(const f32x4*)(bias + c0), b1 = *(const f32x4*)(bias + c0 + 4);
        v[0] += b0.x; v[1] += b0.y; v[2] += b0.z; v[3] += b0.w; v[4] += b1.x; v[5] += b1.y; v[6] += b1.z; v[7] += b1.w; }
    if (region < 2) {
        const int d0 = c0 & 63;
        if (d0 < 16) {
            const f32x4 q0 = *(const f32x4*)(bias + (c0 ^ 8)), q1 = *(const f32x4*)(bias + (c0 ^ 8) + 4);
            const float pb[8] = {q0.x, q0.y, q0.z, q0.w, q1.x, q1.y, q1.z, q1.w};
            const float pos = (float)P.positions[r];
            const float invf[8] = {1.0f, 0.19392274474868576f, 0.03760603093086393f, 0.007292664737217109f, 0.001414213562373095f, 0.0002742481756762073f, 5.318295896944988e-05f, 1.031338537721246e-05f};
            const float sgn = d0 < 8 ? -1.f : 1.f;
#pragma unroll
            for (int j = 0; j < 8; ++j) { const float ang = pos * invf[j]; float rev = ang * 0.15915494309189535f; rev = rev - floorf(rev);
                const float sn = __builtin_amdgcn_sinf(rev), cs = __builtin_amdgcn_cosf(rev);
                v[j] = v[j] * cs + sgn * (pv[j] + pb[j]) * sn; }
        }
        const float sc = region == 0 ? QSCALE : 1.f;
        v4u o; o.x = pk2(v[0] * sc, v[1] * sc); o.y = pk2(v[2] * sc, v[3] * sc); o.z = pk2(v[4] * sc, v[5] * sc); o.w = pk2(v[6] * sc, v[7] * sc);
        *(v4u*)((bf16*)(ws + (region == 0 ? WS_Q : WS_K)) + (size_t)r * HW + cc) = o;
    } else if (region == 4) {
        const float* lb = (const float*)(ws + WS_LB) + cc; float o[8];
#pragma unroll
        for (int j = 0; j < 8; ++j) { const float l = lb[j]; o[j] = __logf(l + (1.f - l) * sigmoid_f(v[j])); }
        float* dst = (float*)(ws + WS_LF) + (size_t)r * HW + cc;
        *(f32x4*)dst = (f32x4){o[0], o[1], o[2], o[3]}; *(f32x4*)(dst + 4) = (f32x4){o[4], o[5], o[6], o[7]};
    } else {
        if (region == 3 || region == 6) {
#pragma unroll
            for (int j = 0; j < 8; ++j) v[j] = silu_f(v[j]); }
        const size_t off = region == 2 ? WS_V : region == 3 ? WS_GQ : region == 5 ? WS_GI : WS_GG;
        v4u o; o.x = pk2(v[0], v[1]); o.y = pk2(v[2], v[3]); o.z = pk2(v[4], v[5]); o.w = pk2(v[6], v[7]);
        *(v4u*)((bf16*)(ws + off) + (size_t)r * HW + cc) = o;
    }
}
__device__ __forceinline__ void outproj_finish(const Params& P, int r, int c0, const float* v) {
    const int b = r >> 12; const float* g1 = (const float*)(P.ws + WS_MOD) + b * 6144 + 2048 + c0;
    const float* xr = P.x + (size_t)r * DM + c0; float* o = P.out + (size_t)r * DM + c0;
    const f32x4 x0 = *(const f32x4*)xr, x1 = *(const f32x4*)(xr + 4), g0 = *(const f32x4*)g1, g4 = *(const f32x4*)(g1 + 4);
    *(f32x4*)o = (f32x4){x0.x + g0.x * v[0], x0.y + g0.y * v[1], x0.z + g0.z * v[2], x0.w + g0.w * v[3]};
    *(f32x4*)(o + 4) = (f32x4){x1.x + g4.x * v[4], x1.y + g4.y * v[5], x1.z + g4.z * v[6], x1.w + g4.w * v[7]};
}
__device__ __forceinline__ void gateup_finish(const Params& P, int rs, int f0, const float* g, const float* u) {
    const float w = ((const float*)(P.ws + WS_ROWW))[rs]; float h[8];
#pragma unroll
    for (int j = 0; j < 8; ++j) h[j] = silu_f(g[j]) * u[j] * w;
    v4u o; o.x = pk2(h[0], h[1]); o.y = pk2(h[2], h[3]); o.z = pk2(h[4], h[5]); o.w = pk2(h[6], h[7]);
    *(v4u*)((bf16*)(P.ws + WS_HM) + (size_t)rs * FF + f0) = o;
}
__device__ __forceinline__ void down_finish(const Params& P, int rs, int c0, const float* v) {
    const int dest = ((const int*)(P.ws + WS_ROWINFO))[rs];
    if (dest >= 0) { v4u o; o.x = pk2(v[0], v[1]); o.y = pk2(v[2], v[3]); o.z = pk2(v[4], v[5]); o.w = pk2(v[6], v[7]);
        *(v4u*)((bf16*)(P.ws + WS_Y) + (size_t)dest * DM + c0) = o; }
}

template <class BRow, class Fin>
__device__ __forceinline__ void naive_gemm(const bf16* A, int M, int N, int K, const BRow& brow, const Fin& fin, int vb, int nvb) {
    const long total = (long)M * (N / 16);
    for (long i = (long)vb * NTHR + threadIdx.x; i < total; i += (long)nvb * NTHR) {
        const int r = (int)(i / (N / 16)), c16 = (int)(i % (N / 16)) * 16;
        float acc[16];
#pragma unroll
        for (int j = 0; j < 16; ++j) acc[j] = 0.f;
        const bf16* a = A + (size_t)r * K;
        for (int k = 0; k < K; k += 8) {
            const v4u av = *(const v4u*)(a + k);
            const float af[8] = {bflo(av.x), bfhi(av.x), bflo(av.y), bfhi(av.y), bflo(av.z), bfhi(av.z), bflo(av.w), bfhi(av.w)};
#pragma unroll
            for (int j = 0; j < 16; ++j) { const v4u bv = *(const v4u*)(brow(r, c16 + j) + k);
                acc[j] += af[0] * bflo(bv.x) + af[1] * bfhi(bv.x) + af[2] * bflo(bv.y) + af[3] * bfhi(bv.y) + af[4] * bflo(bv.z) + af[5] * bfhi(bv.z) + af[6] * bflo(bv.w) + af[7] * bfhi(bv.w); }
        }
        fin(r, c16, acc);
    }
}

struct EpiProj {
    static constexpr bool PERM = true, AFTER_DRAIN = false;
    Params P;
    __device__ __forceinline__ void operator()(const pg8::f32x4 (&acc)[2][2][4][2], const pg8::Unit& u, int wr, int wc, int fr, int fq) const {
        const int pnl = u.pn % 14; const bool rot = (pnl < 4) && !(wc & 1);
#pragma unroll
        for (int ai = 0; ai < 2; ++ai)
#pragma unroll
            for (int m = 0; m < 4; ++m) { const int r = u.pm * 256 + ai * 128 + wr * 64 + m * 16 + fr;
#pragma unroll
                for (int bj = 0; bj < 2; ++bj) { const int c0 = pnl * 256 + bj * 128 + wc * 32 + 8 * fq;
                    float v[8], pv[8];
#pragma unroll
                    for (int n = 0; n < 2; ++n)
#pragma unroll
                        for (int j = 0; j < 4; ++j) v[n * 4 + j] = acc[ai][bj][m][n][j];
                    if (rot) {
#pragma unroll
                        for (int j = 0; j < 8; ++j) pv[j] = __shfl_xor(v[j], 16); }
                    else {
#pragma unroll
                        for (int j = 0; j < 8; ++j) pv[j] = 0.f; }
                    proj_finish(P, r, c0, v, pv); } }
    }
};
struct EpiOut {
    static constexpr bool PERM = true, AFTER_DRAIN = false;
    Params P;
    __device__ __forceinline__ void operator()(const pg8::f32x4 (&acc)[2][2][4][2], const pg8::Unit& u, int wr, int wc, int fr, int fq) const {
#pragma unroll
        for (int ai = 0; ai < 2; ++ai)
#pragma unroll
            for (int m = 0; m < 4; ++m) { const int r = u.pm * 256 + ai * 128 + wr * 64 + m * 16 + fr;
#pragma unroll
                for (int bj = 0; bj < 2; ++bj) { const int c0 = u.pn * 256 + bj * 128 + wc * 32 + 8 * fq; float v[8];
#pragma unroll
                    for (int n = 0; n < 2; ++n)
#pragma unroll
                        for (int j = 0; j < 4; ++j) v[n * 4 + j] = acc[ai][bj][m][n][j];
                    outproj_finish(P, r, c0, v); } }
    }
};
struct EpiGateUp {
    static constexpr bool PERM = true, AFTER_DRAIN = false;
    Params P;
    __device__ __forceinline__ void operator()(const pg8::f32x4 (&acc)[2][2][4][2], const pg8::Unit& u, int wr, int wc, int fr, int fq) const {
        const int pnl = u.pn & 1;
#pragma unroll
        for (int ai = 0; ai < 2; ++ai)
#pragma unroll
            for (int m = 0; m < 4; ++m) { const int rs = u.pm * 256 + ai * 128 + wr * 64 + m * 16 + fr; float g[8], up[8];
#pragma unroll
                for (int n = 0; n < 2; ++n)
#pragma unroll
                    for (int j = 0; j < 4; ++j) { g[n * 4 + j] = acc[ai][0][m][n][j]; up[n * 4 + j] = acc[ai][1][m][n][j]; }
                gateup_finish(P, rs, pnl * 128 + wc * 32 + 8 * fq, g, up); }
    }
};
struct EpiDown {
    static constexpr bool PERM = true, AFTER_DRAIN = false;
    Params P;
    __device__ __forceinline__ void operator()(const pg8::f32x4 (&acc)[2][2][4][2], const pg8::Unit& u, int wr, int wc, int fr, int fq) const {
        const int pnl = u.pn & 3;
#pragma unroll
        for (int ai = 0; ai < 2; ++ai)
#pragma unroll
            for (int m = 0; m < 4; ++m) { const int rs = u.pm * 256 + ai * 128 + wr * 64 + m * 16 + fr;
#pragma unroll
                for (int bj = 0; bj < 2; ++bj) { const int c0 = pnl * 256 + bj * 128 + wc * 32 + 8 * fq; float v[8];
#pragma unroll
                    for (int n = 0; n < 2; ++n)
#pragma unroll
                        for (int j = 0; j < 4; ++j) v[n * 4 + j] = acc[ai][bj][m][n][j];
                    down_finish(P, rs, c0, v); }
                asm volatile("" ::: "memory"); }
    }
};
struct BatchOrder {
    pg8::StaticOrder so;
    __device__ bool next(int i, pg8::Unit& u) const { if (!so.next(i, u)) return false; u.pn += (u.pm >> 4) * 14; return true; }
    __device__ __forceinline__ void a_ready(const pg8::Unit&) const {}
    __device__ __forceinline__ void done(const pg8::Unit&) const {}
};
struct GroupOrder {
    const LAS int* tile_e; int ntiles, NTN, G, c;
    __device__ bool next(int i, pg8::Unit& u) const {
        const int L = i * G + c; if (L >= ntiles * NTN) return false;
        const int rt = L / NTN, j = L % NTN; const int e = __builtin_amdgcn_readfirstlane(tile_e[rt]);
        u.pm = rt; u.pn = e * NTN + j; return true; }
    __device__ __forceinline__ void a_ready(const pg8::Unit&) const {}
    __device__ __forceinline__ void done(const pg8::Unit&) const {}
};

__device__ __forceinline__ int build_tiles(const Params& P, LAS unsigned char* lds) {
    LAS int* lc = (LAS int*)(lds + LDS_CTL_OFF);
    __syncthreads();
    if (threadIdx.x == 0) { const int* cnt = (const int*)(P.ws + WS_CTL) + CW_CNT; int t = 0;
        for (int e = 0; e < NE; ++e) { const int n = (__hip_atomic_load(cnt + e, __ATOMIC_RELAXED, __HIP_MEMORY_SCOPE_AGENT) + 255) >> 8; for (int j = 0; j < n; ++j) lc[LC_TILE_E + t + j] = e; t += n; }
        lc[LC_NTILES] = t; }
    __syncthreads();
    return lc[LC_NTILES];
}

__device__ __forceinline__ void phase_gemm1(const Params& P, LAS unsigned char* lds, int vb, int nvb) {
    unsigned char* ws = P.ws;
#if FAST_GEMM
    pg8::Gemm g{(const bf16*)(ws + WS_XN), (const bf16*)(ws + WS_WB), T, INW, DM}; BatchOrder S; S.so.init(T, INW, nvb, vb);
    EpiProj E{P};
    pg8::gemm_phase<EpiProj, BatchOrder, true, true>(lds, g, S, E);
#else
    const bf16* WB = (const bf16*)(ws + WS_WB);
    naive_gemm((const bf16*)(ws + WS_XN), T, INW, DM,
        [&](int r, int n) { return WB + ((size_t)(r >> 12) * INW + n) * DM; },
        [&](int r, int c16, float* acc) { float pv[8];
#pragma unroll
            for (int j = 0; j < 8; ++j) pv[j] = acc[8 + j];
            float v0[8];
#pragma unroll
            for (int j = 0; j < 8; ++j) v0[j] = acc[j];
            proj_finish(P, r, c16, acc, pv); proj_finish(P, r, c16 + 8, acc + 8, v0); }, vb, nvb);
#endif
}
__device__ __forceinline__ void phase_outproj(const Params& P, LAS unsigned char* lds, int vb, int nvb) {
    unsigned char* ws = P.ws;
#if FAST_GEMM
    pg8::Gemm g{(const bf16*)(ws + WS_MIXED), (const bf16*)(ws + WS_WOT), T, DM, DM}; pg8::StaticOrder S; S.init(T, DM, nvb, vb);
    EpiOut E{P};
    pg8::gemm_phase<EpiOut, pg8::StaticOrder, true, true>(lds, g, S, E);
#else
    const bf16* W = (const bf16*)(ws + WS_WOT);
    naive_gemm((const bf16*)(ws + WS_MIXED), T, DM, DM, [&](int r, int n) { return W + (size_t)n * DM; },
        [&](int r, int c16, float* acc) { outproj_finish(P, r, c16, acc); outproj_finish(P, r, c16 + 8, acc + 8); }, vb, nvb);
#endif
}
__device__ __forceinline__ void phase_gateup(const Params& P, LAS unsigned char* lds, int vb, int nvb) {
    unsigned char* ws = P.ws;
    const int ntiles = build_tiles(P, lds);
#if FAST_GEMM
    pg8::Gemm g{(const bf16*)(ws + WS_XS), (const bf16*)(ws + WS_WGU), XS_ROWS, NE * 512, DM};
    GroupOrder S{(const LAS int*)(lds + LDS_CTL_OFF) + LC_TILE_E, ntiles, 2, nvb, vb};
    EpiGateUp E{P};
    pg8::gemm_phase<EpiGateUp, GroupOrder, true, true>(lds, g, S, E);
#else
    const LAS int* te = (const LAS int*)(lds + LDS_CTL_OFF) + LC_TILE_E; const bf16* W = (const bf16*)(ws + WS_WGU);
    const long total = (long)ntiles * 256 * 16;
    for (long i = (long)vb * NTHR + threadIdx.x; i < total; i += (long)nvb * NTHR) {
        const int rs = (int)(i / 16), f16 = (int)(i % 16) * 16, e = te[rs >> 8];
        float g[16], u[16];
#pragma unroll
        for (int j = 0; j < 16; ++j) { g[j] = 0.f; u[j] = 0.f; }
        const bf16* a = (const bf16*)(ws + WS_XS) + (size_t)rs * DM;
        for (int k = 0; k < DM; k += 8) { const v4u av = *(const v4u*)(a + k);
            const float af[8] = {bflo(av.x), bfhi(av.x), bflo(av.y), bfhi(av.y), bflo(av.z), bfhi(av.z), bflo(av.w), bfhi(av.w)};
#pragma unroll
            for (int j = 0; j < 16; ++j) { const int f = f16 + j; const int rowg = 256 * (f >> 7) + (f & 127);
                const v4u bg = *(const v4u*)(W + ((size_t)e * 512 + rowg) * DM + k), bu = *(const v4u*)(W + ((size_t)e * 512 + rowg + 128) * DM + k);
                g[j] += af[0] * bflo(bg.x) + af[1] * bfhi(bg.x) + af[2] * bflo(bg.y) + af[3] * bfhi(bg.y) + af[4] * bflo(bg.z) + af[5] * bfhi(bg.z) + af[6] * bflo(bg.w) + af[7] * bfhi(bg.w);
                u[j] += af[0] * bflo(bu.x) + af[1] * bfhi(bu.x) + af[2] * bflo(bu.y) + af[3] * bfhi(bu.y) + af[4] * bflo(bu.z) + af[5] * bfhi(bu.z) + af[6] * bflo(bu.w) + af[7] * bfhi(bu.w); } }
        gateup_finish(P, rs, f16, g, u); gateup_finish(P, rs, f16 + 8, g + 8, u + 8);
    }
#endif
}
__device__ __forceinline__ void phase_down(const Params& P, LAS unsigned char* lds, int vb, int nvb) {
    unsigned char* ws = P.ws;
    const int ntiles = build_tiles(P, lds);
#if FAST_GEMM
    pg8::Gemm g{(const bf16*)(ws + WS_HM), (const bf16*)(ws + WS_WD), XS_ROWS, NE * DM, FF + P.ph_lo};
    GroupOrder S{(const LAS int*)(lds + LDS_CTL_OFF) + LC_TILE_E, ntiles, 4, nvb, vb};
    EpiDown E{P};
    pg8::gemm_phase<EpiDown, GroupOrder, true, true>(lds, g, S, E);
#else
    const LAS int* te = (const LAS int*)(lds + LDS_CTL_OFF) + LC_TILE_E; const bf16* W = (const bf16*)(ws + WS_WD);
    naive_gemm((const bf16*)(ws + WS_HM), ntiles * 256, DM, FF, [&](int r, int n) { return W + ((size_t)te[r >> 8] * DM + n) * FF; },
        [&](int r, int c16, float* acc) { down_finish(P, r, c16, acc); down_finish(P, r, c16 + 8, acc + 8); }, vb, nvb);
#endif
}

__device__ __forceinline__ float diff_lambda(const Params& P, int lane) {
    const float s1 = wave_sum(P.lq1[lane] * P.lk1[lane]), s2 = wave_sum(P.lq2[lane] * P.lk2[lane]);
    return __expf(s1) - __expf(s2) + 0.2f;
}
__device__ __forceinline__ void naive_attn(const Params& P, LAS unsigned char* lds, int vb, int nvb) {
    const int tid = threadIdx.x, lane = tid & 63, wave = tid >> 6; unsigned char* ws = P.ws;
    const bf16* Q = (const bf16*)(ws + WS_Q); const bf16* K = (const bf16*)(ws + WS_K); const bf16* V = (const bf16*)(ws + WS_V); bf16* MX = (bf16*)(ws + WS_MIXED);
    LAS float* qs = (LAS float*)(lds + wave * 512);
    const float lam = diff_lambda(P, lane);
    for (int task = vb * NWAVES + wave; task < NB * 4 * SEQ; task += nvb * NWAVES) {
        const int q = task % SEQ, bh = task / SEQ, h = bh & 3, b = bh >> 2; const size_t row = (size_t)b * SEQ + q;
        { const unsigned w = *(const unsigned*)(Q + row * HW + h * 128 + 2 * lane); qs[2 * lane] = bflo(w); qs[2 * lane + 1] = bfhi(w); }
        LDS_WAIT(); asm volatile("" ::: "memory");
        float m0 = -INFINITY, m1 = -INFINITY, l0 = 0.f, l1 = 0.f, o00 = 0.f, o01 = 0.f, o10 = 0.f, o11 = 0.f;
        for (int kc = 0; kc * 64 <= q; ++kc) {
            const int key = kc * 64 + lane; const bool valid = key <= q;
            const bf16* kr = K + ((size_t)b * SEQ + key) * HW + h * 128; float s0 = 0.f, s1 = 0.f;
#pragma unroll
            for (int d = 0; d < 64; d += 8) { const v4u a = *(const v4u*)(kr + d), c2 = *(const v4u*)(kr + 64 + d);
                s0 += qs[d] * bflo(a.x) + qs[d + 1] * bfhi(a.x) + qs[d + 2] * bflo(a.y) + qs[d + 3] * bfhi(a.y) + qs[d + 4] * bflo(a.z) + qs[d + 5] * bfhi(a.z) + qs[d + 6] * bflo(a.w) + qs[d + 7] * bfhi(a.w);
                s1 += qs[64 + d] * bflo(c2.x) + qs[65 + d] * bfhi(c2.x) + qs[66 + d] * bflo(c2.y) + qs[67 + d] * bfhi(c2.y) + qs[68 + d] * bflo(c2.z) + qs[69 + d] * bfhi(c2.z) + qs[70 + d] * bflo(c2.w) + qs[71 + d] * bfhi(c2.w); }
            if (!valid) { s0 = -INFINITY; s1 = -INFINITY; }
            const float n0 = fmaxf(m0, wave_max(s0)), n1 = fmaxf(m1, wave_max(s1));
            const float p0 = valid ? exp2f(s0 - n0) : 0.f, p1 = valid ? exp2f(s1 - n1) : 0.f;
            const float a0 = exp2f(m0 - n0), a1 = exp2f(m1 - n1);
            l0 = l0 * a0 + wave_sum(p0); l1 = l1 * a1 + wave_sum(p1); o00 *= a0; o01 *= a0; o10 *= a1; o11 *= a1; m0 = n0; m1 = n1;
            const bf16* vr = V + ((size_t)b * SEQ + kc * 64) * HW + h * 128 + 2 * lane;
            for (int kk = 0; kk < 64; ++kk) { const float pa = __shfl(p0, kk), pb = __shfl(p1, kk); const unsigned w = *(const unsigned*)(vr + (size_t)kk * HW);
                const float va = bflo(w), vb2 = bfhi(w); o00 += pa * va; o01 += pa * vb2; o10 += pb * va; o11 += pb * vb2; }
        }
        const float r0 = o00 / l0 - lam * o10 / l1, r1 = o01 / l0 - lam * o11 / l1;
        const float rstd = rsqrtf(wave_sum(r0 * r0 + r1 * r1) * (1.f / 128.f) + EPS);
        *(unsigned*)(MX + row * DM + h * 128 + 2 * lane) = pk2(r0 * rstd * P.subln_w[2 * lane] * 0.8f, r1 * rstd * P.subln_w[2 * lane + 1] * 0.8f);
        asm volatile("" ::: "memory");
    }
}
__device__ __forceinline__ void naive_hgrn_rec(const Params& P, int vb, int nvb) {
    const int tid = threadIdx.x; unsigned char* ws = P.ws;
    const bf16* GQ = (const bf16*)(ws + WS_GQ); const bf16* GI = (const bf16*)(ws + WS_GI); const float* LF = (const float*)(ws + WS_LF);
    float* OB = (float*)((unsigned char*)P.out + DO_ONAIVE);
    for (int grp = vb * 4 + (tid >> 7); grp < 16; grp += nvb * 4) {
        const int b = grp >> 2, h = grp & 3, v = tid & 127;
        float S[128];
#pragma unroll
        for (int k = 0; k < 128; ++k) S[k] = 0.f;
        for (int t = 0; t < SEQ; ++t) {
            const size_t base = ((size_t)b * SEQ + t) * HW + h * 128;
            const float vv = bf2f(GI[base + v]); float o = 0.f;
#pragma unroll
            for (int k = 0; k < 128; k += 4) { const f32x4 lf = *(const f32x4*)(LF + base + k); const v2u qw = *(const v2u*)(GQ + base + k);
                const float f0 = __expf(lf.x), f1 = __expf(lf.y), f2 = __expf(lf.z), f3 = __expf(lf.w);
                S[k] = f0 * S[k] + (1.f - f0) * vv; S[k + 1] = f1 * S[k + 1] + (1.f - f1) * vv; S[k + 2] = f2 * S[k + 2] + (1.f - f2) * vv; S[k + 3] = f3 * S[k + 3] + (1.f - f3) * vv;
                o += S[k] * bflo(qw.x) + S[k + 1] * bfhi(qw.x) + S[k + 2] * bflo(qw.y) + S[k + 3] * bfhi(qw.y); }
            OB[base + v] = o;
        }
    }
}
__device__ __forceinline__ void naive_hgrn_norm(const Params& P, int vb, int nvb) {
    const int tid = threadIdx.x, lane = tid & 63, wave = tid >> 6; unsigned char* ws = P.ws;
    const float* OB = (const float*)((unsigned char*)P.out + DO_ONAIVE); const bf16* GG = (const bf16*)(ws + WS_GG); bf16* MX = (bf16*)(ws + WS_MIXED);
    for (int task = vb * NWAVES + wave; task < T * 4; task += nvb * NWAVES) {
        const int row = task >> 2, h = task & 3; const size_t base = (size_t)row * HW + h * 128 + 2 * lane;
        const f32x2 o = *(const f32x2*)(OB + base); const float rstd = rsqrtf(wave_sum(o.x * o.x + o.y * o.y) * (1.f / 128.f) + EPS);
        const unsigned g = *(const unsigned*)(GG + base);
        *(unsigned*)(MX + (size_t)row * DM + 512 + h * 128 + 2 * lane) = pk2(o.x * rstd * P.hg_norm_w[2 * lane] * bflo(g), o.y * rstd * P.hg_norm_w[2 * lane + 1] * bfhi(g));
    }
}

__device__ __forceinline__ void phase_route(const Params& P, int vb, int nvb) {
    const int tid = threadIdx.x, lane = tid & 63, wave = tid >> 6; unsigned char* ws = P.ws;
    const float* mod = (const float*)(ws + WS_MOD); const float* WRT = (const float*)(ws + WS_WRT);
    int* cnt = (int*)(ws + WS_CTL) + CW_CNT;
    for (int t = vb * NWAVES + wave; t < T; t += nvb * NWAVES) {
        const int b = t >> 12;
        const f32x4* xr = (const f32x4*)(P.out + (size_t)t * DM) + lane;
        f32x4 v[4]; float s = 0.f;
#pragma unroll
        for (int j = 0; j < 4; ++j) { v[j] = xr[64 * j]; s += (v[j].x * v[j].x + v[j].y * v[j].y) + (v[j].z * v[j].z + v[j].w * v[j].w); }
        const float rstd = rsqrtf(wave_sum(s) * (1.f / DM) + EPS);
        unsigned long long* o8 = (unsigned long long*)((bf16*)(ws + WS_H2) + (size_t)t * DM) + lane;
#pragma unroll
        for (int j = 0; j < 4; ++j) { const int d = 4 * lane + 256 * j;
            const f32x4 nw = *(const f32x4*)(P.norm2_w + d), sc = *(const f32x4*)(mod + b * 6144 + 4096 + d), sh = *(const f32x4*)(mod + b * 6144 + 3072 + d);
            v[j].x = v[j].x * rstd * nw.x * (1.f + sc.x) + sh.x; v[j].y = v[j].y * rstd * nw.y * (1.f + sc.y) + sh.y;
            v[j].z = v[j].z * rstd * nw.z * (1.f + sc.z) + sh.z; v[j].w = v[j].w * rstd * nw.w * (1.f + sc.w) + sh.w;
            o8[64 * j] = (unsigned long long)pk2(v[j].x, v[j].y) | ((unsigned long long)pk2(v[j].z, v[j].w) << 32); }
        float myL = 0.f;
#pragma unroll 2
        for (int jj = 0; jj < 36; ++jj) { const f32x4* wr_ = (const f32x4*)(WRT + jj * 1024) + lane; float a = 0.f;
#pragma unroll
            for (int j = 0; j < 4; ++j) { const f32x4 w = wr_[64 * j]; a += (v[j].x * w.x + v[j].y * w.y) + (v[j].z * w.z + v[j].w * w.w); }
            a = wave_sum(a); if (lane == jj) myL = a; }
        float L[36];
#pragma unroll
        for (int jj = 0; jj < 36; ++jj) L[jj] = __shfl(myL, jj);
        float gl[4];
#pragma unroll
        for (int i = 0; i < 4; ++i) gl[i] = L[i] + P.b_group[i];
        int g = 0; float gm = gl[0];
#pragma unroll
        for (int i = 1; i < 4; ++i) if (gl[i] > gm) { gm = gl[i]; g = i; }
        float gs = 0.f;
#pragma unroll
        for (int i = 0; i < 4; ++i) gs += __expf(gl[i] - gm);
        const float gw_ = 1.f / gs;
        float el[8];
#pragma unroll
        for (int i = 0; i < 8; ++i) { const float a0 = L[4 + i] + P.b_router[i], a1 = L[12 + i] + P.b_router[8 + i], a2 = L[20 + i] + P.b_router[16 + i], a3 = L[28 + i] + P.b_router[24 + i];
            el[i] = g == 0 ? a0 : g == 1 ? a1 : g == 2 ? a2 : a3; }
        int i1 = 0; float e1 = el[0];
#pragma unroll
        for (int i = 1; i < 8; ++i) if (el[i] > e1) { e1 = el[i]; i1 = i; }
        int i2 = -1; float e2 = -INFINITY;
#pragma unroll
        for (int i = 0; i < 8; ++i) if (i != i1 && el[i] > e2) { e2 = el[i]; i2 = i; }
        const float w1 = 1.f / (1.f + __expf(e2 - e1)), w2 = 1.f - w1;
        if (lane == 0) {
            const int ea = g * 8 + i1, eb = g * 8 + i2;
            const int pa = atomicAdd(cnt + ea, 1), pb = atomicAdd(cnt + eb, 1);
            int* te = (int*)(ws + WS_TOKE) + 2 * t; float* tw = (float*)(ws + WS_TOKW) + 2 * t; int* tp = (int*)(ws + WS_TOKP) + 2 * t;
            te[0] = ea; te[1] = eb; tw[0] = w1 * gw_; tw[1] = w2 * gw_; tp[0] = pa; tp[1] = pb;
        }
    }
}
__device__ __forceinline__ void phase_scatter(const Params& P, LAS unsigned char* lds, int vb, int nvb) {
    const int tid = threadIdx.x, lane = tid & 63, wave = tid >> 6; unsigned char* ws = P.ws;
    LAS int* off = (LAS int*)(lds + LDS_CTL_OFF) + 256;
    __syncthreads();
    if (tid == 0) { const int* cnt = (const int*)(ws + WS_CTL) + CW_CNT; int o = 0;
        for (int e = 0; e < NE; ++e) { const int n = __hip_atomic_load(cnt + e, __ATOMIC_RELAXED, __HIP_MEMORY_SCOPE_AGENT); off[e] = o; off[40 + e] = n; o += ((n + 255) >> 8) << 8; }
        off[32] = o; }
    __syncthreads();
    int* rinfo = (int*)(ws + WS_ROWINFO); float* roww = (float*)(ws + WS_ROWW); bf16* XS = (bf16*)(ws + WS_XS);
    for (int t = vb * NWAVES + wave; t < T; t += nvb * NWAVES) {
        const int* te = (const int*)(ws + WS_TOKE) + 2 * t; const float* tw = (const float*)(ws + WS_TOKW) + 2 * t; const int* tp = (const int*)(ws + WS_TOKP) + 2 * t;
        const v4u* src = (const v4u*)((const bf16*)(ws + WS_H2) + (size_t)t * DM) + lane; const v4u a = src[0], c2 = src[64];
#pragma unroll
        for (int s = 0; s < 2; ++s) { const int rs = off[te[s]] + tp[s]; v4u* dst = (v4u*)(XS + (size_t)rs * DM) + lane; dst[0] = a; dst[64] = c2;
            if (lane == 0) { rinfo[rs] = 2 * t + s; roww[rs] = tw[s]; } }
    }
    for (int e = 0; e < NE; ++e) { const int n = off[40 + e], r0 = off[e] + n, r1 = off[e + 1];
        for (int rs = r0 + vb * NWAVES + wave; rs < r1; rs += nvb * NWAVES) { v4u* dst = (v4u*)(XS + (size_t)rs * DM) + lane; const v4u z = {0u, 0u, 0u, 0u}; dst[0] = z; dst[64] = z;
            if (lane == 0) { rinfo[rs] = -1; roww[rs] = 0.f; } } }
}
__device__ __forceinline__ void phase_final(const Params& P, int vb, int nvb) {
    const int tid = threadIdx.x, lane = tid & 63, wave = tid >> 6; unsigned char* ws = P.ws; const float* mod = (const float*)(ws + WS_MOD);
    for (int t = vb * NWAVES + wave; t < T; t += nvb * NWAVES) {
        const int b = t >> 12;
        f32x4* xr = (f32x4*)(P.out + (size_t)t * DM) + lane;
        const v2u* y0 = (const v2u*)((const bf16*)(ws + WS_Y) + (size_t)(2 * t) * DM) + lane; const v2u* y1 = y0 + DM / 4;
        f32x4 v[4]; float s = 0.f;
#pragma unroll
        for (int j = 0; j < 4; ++j) { const int d = 4 * lane + 256 * j; const f32x4 g2 = *(const f32x4*)(mod + b * 6144 + 5120 + d); const v2u a = y0[64 * j], c2 = y1[64 * j];
            v[j] = xr[64 * j];
            v[j].x += g2.x * (bflo(a.x) + bflo(c2.x)); v[j].y += g2.y * (bfhi(a.x) + bfhi(c2.x)); v[j].z += g2.z * (bflo(a.y) + bflo(c2.y)); v[j].w += g2.w * (bfhi(a.y) + bfhi(c2.y));
            s += (v[j].x * v[j].x + v[j].y * v[j].y) + (v[j].z * v[j].z + v[j].w * v[j].w); }
        const float rstd = rsqrtf(wave_sum(s) * (1.f / DM) + EPS);
#pragma unroll
        for (int j = 0; j < 4; ++j) { const f32x4 fw = *(const f32x4*)(P.final_norm_w + 4 * lane + 256 * j);
            xr[64 * j] = (f32x4){v[j].x * rstd * fw.x, v[j].y * rstd * fw.y, v[j].z * rstd * fw.z, v[j].w * rstd * fw.w}; }
    }
}

#define MFMA32(a, b, c) __builtin_amdgcn_mfma_f32_32x32x16_bf16((a), (b), (c), 0, 0, 0)
typedef __attribute__((address_space(3))) const char* lds_cptr;
typedef short v4i16_t __attribute__((ext_vector_type(4)));
typedef __bf16 bf16x2_t __attribute__((ext_vector_type(2)));
__device__ __forceinline__ s16x4 vtr(lds_cptr p) { return __builtin_bit_cast(s16x4, __builtin_amdgcn_ds_read_tr16_b64_v4i16((LAS v4i16_t*)p)); }
__device__ __forceinline__ int crow(int i, int hi) { return (i & 3) + 8 * (i >> 2) + 4 * hi; }
__device__ __forceinline__ unsigned cvtpk(float lo, float hi) { f32x2 v = {lo, hi}; bf16x2_t b = __builtin_convertvector(v, bf16x2_t); return __builtin_bit_cast(unsigned, b); }
#define PACK8(x, s) __builtin_bit_cast(bf16x8, (v4u){cvtpk((x)[8 * (s)], (x)[8 * (s) + 1]), cvtpk((x)[8 * (s) + 2], (x)[8 * (s) + 3]), cvtpk((x)[8 * (s) + 4], (x)[8 * (s) + 5]), cvtpk((x)[8 * (s) + 6], (x)[8 * (s) + 7])})
#define VFRAG(lo, hi4) (bf16x8){(lo)[0], (lo)[1], (lo)[2], (lo)[3], (hi4)[0], (hi4)[1], (hi4)[2], (hi4)[3]}
__device__ __forceinline__ void vtile_load(const bf16* g, int pitch, int wave, int lane, v4u (&reg)[2]) {
#pragma unroll
    for (int i = 0; i < 2; ++i) { const int pi = wave + 8 * i; reg[i] = *(const v4u*)(g + (size_t)(16 * (pi & 3) + (lane >> 2)) * pitch + (pi >> 2) * 32 + (lane & 3) * 8); }
}
__device__ __forceinline__ void vtile_store(LAS unsigned char* vbuf, int wave, int lane, const v4u (&reg)[2]) {
#pragma unroll
    for (int i = 0; i < 2; ++i) *(LAS v4u*)(vbuf + (wave + 8 * i) * 1024 + lane * 16) = reg[i];
}
__device__ __forceinline__ void ktile_load(const bf16* g, int pitch, int wave, int lane, v4u (&reg)[2]) {
#pragma unroll
    for (int i = 0; i < 2; ++i) reg[i] = *(const v4u*)(g + (size_t)lane * pitch + (wave + 8 * i) * 8);
}
__device__ __forceinline__ void ktile_store(LAS unsigned char* kbuf, int wave, int lane, const v4u (&reg)[2]) {
#pragma unroll
    for (int i = 0; i < 2; ++i) *(LAS v4u*)(kbuf + (wave + 8 * i) * 1024 + lane * 16) = reg[i];
}

#if FAST_ATTN
__device__ __forceinline__ void attn_unit(const Params& P, LAS unsigned char* lds, int b, int h, int qb, float lam) {
    const int tid = threadIdx.x, lane = tid & 63, r32 = lane & 31, hi = lane >> 5, wave = __builtin_amdgcn_readfirstlane(tid >> 6), m = wave >> 2, ws4 = wave & 3;
    unsigned char* ws = P.ws;
    const bf16* Kg = (const bf16*)(ws + WS_K) + (size_t)b * SEQ * HW + h * 128; const bf16* Vg = (const bf16*)(ws + WS_V) + (size_t)b * SEQ * HW + h * 128;
    const int q0 = qb * 128, NT = 2 * qb + 2, rowq = q0 + 32 * ws4 + r32, wrow0 = q0 + 32 * ws4;
    bf16x8 qf[4];
    { const bf16* Qg = (const bf16*)(ws + WS_Q) + ((size_t)b * SEQ + rowq) * HW + h * 128 + m * 64 + 8 * hi;
#pragma unroll
      for (int ks = 0; ks < 4; ++ks) qf[ks] = *(const bf16x8*)(Qg + 16 * ks); }
    v4u kr[2], vr[2];
    ktile_load(Kg, HW, wave, lane, kr); vtile_load(Vg, HW, wave, lane, vr);
    ktile_store(lds, wave, lane, kr); vtile_store(lds + 32768, wave, lane, vr);
    __syncthreads();
    f32x16 o[4];
#pragma unroll
    for (int d = 0; d < 4; ++d)
#pragma unroll
        for (int i = 0; i < 16; ++i) o[d][i] = 0.f;
    float mrun = -INFINITY, lrun = 0.f;
    const int voff = ((lane >> 4) & 1) * 32 + (lane & 3) * 8 + (4 * hi + ((lane & 15) >> 2)) * 64;
    for (int t = 0; t < NT; ++t) {
        LAS unsigned char* kbuf = lds + (t & 1) * 16384; LAS unsigned char* vbuf = lds + 32768 + (t & 1) * 16384;
        const bool more = t + 1 < NT;
        if (more) { ktile_load(Kg + (size_t)(t + 1) * 64 * HW, HW, wave, lane, kr); vtile_load(Vg + (size_t)(t + 1) * 64 * HW, HW, wave, lane, vr); }
        const int kbase = 64 * t;
        if (kbase <= wrow0 + 31) {
            f32x16 s0, s1;
#pragma unroll
            for (int i = 0; i < 16; ++i) { s0[i] = 0.f; s1[i] = 0.f; }
#pragma unroll
            for (int ks = 0; ks < 4; ++ks) { lds_cptr kp = (lds_cptr)kbuf + (m * 8 + 2 * ks + hi) * 1024 + r32 * 16;
                const bf16x8 k0 = *(const LAS bf16x8*)kp, k1 = *(const LAS bf16x8*)(kp + 512);
                s0 = MFMA32(k0, qf[ks], s0); s1 = MFMA32(k1, qf[ks], s1); }
            if (kbase + 63 > wrow0) {
#pragma unroll
                for (int i = 0; i < 16; ++i) { const int key = kbase + crow(i, hi); if (key > rowq) s0[i] = -INFINITY; if (key + 32 > rowq) s1[i] = -INFINITY; } }
            float mx = fmaxf(s0[0], s1[0]);
#pragma unroll
            for (int i = 1; i < 16; ++i) mx = fmaxf(mx, fmaxf(s0[i], s1[i]));
            mx = fmaxf(mx, __shfl_xor(mx, 32));
            const float mnew = fmaxf(mrun, mx), alpha = __builtin_amdgcn_exp2f(mrun - mnew); mrun = mnew;
            float rs = 0.f;
#pragma unroll
            for (int i = 0; i < 16; ++i) { s0[i] = __builtin_amdgcn_exp2f(s0[i] - mnew); s1[i] = __builtin_amdgcn_exp2f(s1[i] - mnew); rs += s0[i] + s1[i]; }
            lrun = lrun * alpha + rs;
#pragma unroll
            for (int d = 0; d < 4; ++d)
#pragma unroll
                for (int i = 0; i < 16; ++i) o[d][i] *= alpha;
            lds_cptr vp = (lds_cptr)vbuf + voff;
#pragma unroll
            for (int ks4 = 0; ks4 < 4; ++ks4) {
                const bf16x8 pf = (ks4 == 0) ? PACK8(s0, 0) : (ks4 == 1) ? PACK8(s0, 1) : (ks4 == 2) ? PACK8(s1, 0) : PACK8(s1, 1);
#pragma unroll
                for (int d = 0; d < 4; ++d) { const s16x4 lo = vtr(vp + d * 4096 + ks4 * 1024), h4 = vtr(vp + d * 4096 + ks4 * 1024 + 512);
                    o[d] = MFMA32(VFRAG(lo, h4), pf, o[d]); } }
        }
        if (more) { ktile_store(lds + ((t + 1) & 1) * 16384, wave, lane, kr); vtile_store(lds + 32768 + ((t + 1) & 1) * 16384, wave, lane, vr); }
        __syncthreads();
    }
    lrun += __shfl_xor(lrun, 32);
    const float inv = 1.f / lrun;
    LAS float* xch = (LAS float*)lds + ws4 * 4096;
    if (m == 1) {
#pragma unroll
        for (int d = 0; d < 4; ++d)
#pragma unroll
            for (int i = 0; i < 16; ++i) xch[(d * 16 + i) * 64 + lane] = o[d][i] * inv; }
    __syncthreads();
    if (m == 0) {
        float ss = 0.f;
#pragma unroll
        for (int d = 0; d < 4; ++d)
#pragma unroll
            for (int i = 0; i < 16; ++i) { const float v = o[d][i] * inv - lam * xch[(d * 16 + i) * 64 + lane]; o[d][i] = v; ss += v * v; }
        ss += __shfl_xor(ss, 32);
        const float rstd = rsqrtf(ss * (1.f / 128.f) + EPS) * 0.8f;
        bf16* dst = (bf16*)(ws + WS_MIXED) + ((size_t)b * SEQ + rowq) * DM + h * 128;
#pragma unroll
        for (int d = 0; d < 4; ++d)
#pragma unroll
            for (int g = 0; g < 4; ++g) { const int dv0 = 32 * d + 8 * g + 4 * hi; const f32x4 w = *(const f32x4*)(P.subln_w + dv0);
                v2u pk; pk.x = pk2(o[d][4 * g] * rstd * w.x, o[d][4 * g + 1] * rstd * w.y); pk.y = pk2(o[d][4 * g + 2] * rstd * w.z, o[d][4 * g + 3] * rstd * w.w);
                *(v2u*)(dst + dv0) = pk; }
    }
    __syncthreads();
}
__device__ __forceinline__ void attn_phase(const Params& P, LAS unsigned char* lds, int vb, int nvb) {
    const float lam = diff_lambda(P, threadIdx.x & 63);
    for (int u = vb; u < 256; u += nvb) { const int bh = u >> 4, p = u & 15, b = bh >> 2, h = bh & 3;
        attn_unit(P, lds, b, h, 31 - p, lam); attn_unit(P, lds, b, h, p, lam); }
}
#endif

#if FAST_HGRN
__device__ __forceinline__ void hgrn_pass_a(const Params& P, LAS unsigned char* lds, int vb, int nvb) {
    const int tid = threadIdx.x, lane = tid & 63, r32 = lane & 31, hi = lane >> 5, wave = __builtin_amdgcn_readfirstlane(tid >> 6), k = tid & 127, seg = tid >> 7;
    unsigned char* ws = P.ws;
    LAS float* tot = (LAS float*)lds; LAS unsigned char* ktT = lds + 2048; LAS unsigned char* vimg = lds + 20480;
    const float* LF = (const float*)(ws + WS_LF); const bf16* GI = (const bf16*)(ws + WS_GI);
    bf16* U = (bf16*)((unsigned char*)P.out + DO_U); float* Dd = (float*)((unsigned char*)P.out + DO_D);
    for (int u = vb; u < 1024; u += nvb) {
        const int bh = u >> 6, c = u & 63, b = bh >> 2, h = bh & 3; const size_t row0 = (size_t)b * SEQ + c * 64;
        { v4u vr[2]; vtile_load(GI + row0 * HW + h * 128, HW, wave, lane, vr); vtile_store(vimg, wave, lane, vr); }
        float lf[16], bc[16], run = 0.f;
#pragma unroll
        for (int i = 0; i < 16; ++i) lf[i] = LF[(row0 + seg * 16 + i) * HW + h * 128 + k];
#pragma unroll
        for (int i = 0; i < 16; ++i) { run += lf[i]; bc[i] = run; }
        tot[seg * 128 + k] = run;
        __syncthreads();
        float pre = 0.f, all = 0.f;
#pragma unroll
        for (int s = 0; s < 4; ++s) { const float tv = tot[s * 128 + k]; all += tv; if (s < seg) pre += tv; }
        unsigned w[8];
#pragma unroll
        for (int i = 0; i < 8; ++i) { const float a = (1.f - __expf(lf[2 * i])) * __expf(all - pre - bc[2 * i]), c2 = (1.f - __expf(lf[2 * i + 1])) * __expf(all - pre - bc[2 * i + 1]); w[i] = pk2(a, c2); }
        *(LAS v4u*)(ktT + k * 144 + seg * 32) = (v4u){w[0], w[1], w[2], w[3]}; *(LAS v4u*)(ktT + k * 144 + seg * 32 + 16) = (v4u){w[4], w[5], w[6], w[7]};
        if (seg == 0) Dd[(size_t)u * 128 + k] = __expf(all);
        __syncthreads();
        const int vbk = wave >> 1, kb2 = (wave & 1) * 2;
        f32x16 a0, a1;
#pragma unroll
        for (int i = 0; i < 16; ++i) { a0[i] = 0.f; a1[i] = 0.f; }
        lds_cptr vp = (lds_cptr)vimg + vbk * 4096 + ((lane >> 4) & 1) * 32 + (lane & 3) * 8 + (8 * hi + ((lane & 15) >> 2)) * 64;
#pragma unroll
        for (int s = 0; s < 4; ++s) { const s16x4 lo = vtr(vp + s * 1024), h4 = vtr(vp + s * 1024 + 256); const bf16x8 vf = VFRAG(lo, h4);
            const bf16x8 k0 = *(const LAS bf16x8*)(ktT + (32 * kb2 + r32) * 144 + (16 * s + 8 * hi) * 2), k1 = *(const LAS bf16x8*)(ktT + (32 * kb2 + 32 + r32) * 144 + (16 * s + 8 * hi) * 2);
            a0 = MFMA32(vf, k0, a0); a1 = MFMA32(vf, k1, a1); }
        bf16* Ub = U + (size_t)u * 16384;
#pragma unroll
        for (int i = 0; i < 16; ++i) { const int v = 32 * vbk + crow(i, hi); Ub[v * 128 + 32 * kb2 + r32] = (bf16)f2bf(a0[i]); Ub[v * 128 + 32 * kb2 + 32 + r32] = (bf16)f2bf(a1[i]); }
        __syncthreads();
    }
}
__device__ __forceinline__ void hgrn_pass_b(const Params& P, int vb, int nvb) {
    unsigned* U = (unsigned*)((unsigned char*)P.out + DO_U); const float* Dd = (const float*)((unsigned char*)P.out + DO_D);
    for (int idx = vb * NTHR + threadIdx.x; idx < 16 * 128 * 64; idx += nvb * NTHR) {
        const int bh = idx >> 13, rem = idx & 8191, v = rem >> 6, kp = rem & 63;
        unsigned* up = U + (size_t)bh * 64 * 8192 + v * 64 + kp; const float* dp = Dd + (size_t)bh * 64 * 128 + 2 * kp;
        float s0 = 0.f, s1 = 0.f;
#pragma unroll 8
        for (int c = 0; c < 64; ++c) { const unsigned w = up[(size_t)c * 8192]; const f32x2 d = *(const f32x2*)(dp + c * 128);
            up[(size_t)c * 8192] = pk2(s0, s1); s0 = d.x * s0 + bflo(w); s1 = d.y * s1 + bfhi(w); }
    }
}
__device__ __forceinline__ void hgrn_pass_c(const Params& P, LAS unsigned char* lds, int vb, int nvb) {
    const int tid = threadIdx.x, lane = tid & 63, r32 = lane & 31, hi = lane >> 5, wave = __builtin_amdgcn_readfirstlane(tid >> 6), k = tid & 127, seg = tid >> 7;
    unsigned char* ws = P.ws;
    LAS float* tot = (LAS float*)lds; LAS float* part = (LAS float*)(lds + 2048); LAS unsigned char* qt = lds + 4096; LAS unsigned char* kh = lds + 21504; LAS unsigned char* vimg = lds + 38912;
    const float* LF = (const float*)(ws + WS_LF); const bf16* GI = (const bf16*)(ws + WS_GI); const bf16* GQ = (const bf16*)(ws + WS_GQ); const bf16* GG = (const bf16*)(ws + WS_GG);
    const bf16* U = (const bf16*)((unsigned char*)P.out + DO_U); bf16* MX = (bf16*)(ws + WS_MIXED);
    for (int u = vb; u < 1024; u += nvb) {
        const int bh = u >> 6, c = u & 63, b = bh >> 2, h = bh & 3; const size_t row0 = (size_t)b * SEQ + c * 64;
        { v4u vr[2]; vtile_load(GI + row0 * HW + h * 128, HW, wave, lane, vr); vtile_store(vimg, wave, lane, vr); }
        float lf[16], bc[16], run = 0.f; unsigned short qv[16];
#pragma unroll
        for (int i = 0; i < 16; ++i) { lf[i] = LF[(row0 + seg * 16 + i) * HW + h * 128 + k]; qv[i] = GQ[(row0 + seg * 16 + i) * HW + h * 128 + k]; }
#pragma unroll
        for (int i = 0; i < 16; ++i) { run += lf[i]; bc[i] = run; }
        tot[seg * 128 + k] = run;
        __syncthreads();
        float pre = 0.f;
#pragma unroll
        for (int s = 0; s < 3; ++s) { const float tv = tot[s * 128 + k]; if (s < seg) pre += tv; }
#pragma unroll
        for (int i = 0; i < 16; ++i) { const int t = seg * 16 + i; const float bb = pre + bc[i];
            *(LAS unsigned short*)(qt + t * 272 + k * 2) = (unsigned short)f2bf(bf2f(qv[i]) * __expf(bb));
            *(LAS unsigned short*)(kh + t * 272 + k * 2) = (unsigned short)f2bf((1.f - __expf(lf[i])) * __expf(-bb)); }
        __syncthreads();
        const int vbk = wave >> 1, tb = wave & 1;
        f32x16 acc;
#pragma unroll
        for (int i = 0; i < 16; ++i) acc[i] = 0.f;
        bf16x8 bq[8];
        { const bf16* Sg = U + (size_t)u * 16384 + (32 * vbk + r32) * 128 + 8 * hi;
#pragma unroll
          for (int ks = 0; ks < 8; ++ks) { const bf16x8 a = *(const bf16x8*)(Sg + 16 * ks); bq[ks] = *(const LAS bf16x8*)(qt + (32 * tb + r32) * 272 + (16 * ks + 8 * hi) * 2); acc = MFMA32(a, bq[ks], acc); } }
        for (int sb = 0; sb <= tb; ++sb) {
            f32x16 sc;
#pragma unroll
            for (int i = 0; i < 16; ++i) sc[i] = 0.f;
#pragma unroll
            for (int ks = 0; ks < 8; ++ks) { const bf16x8 kf = *(const LAS bf16x8*)(kh + (32 * sb + r32) * 272 + (16 * ks + 8 * hi) * 2); sc = MFMA32(kf, bq[ks], sc); }
            if (sb == tb) {
#pragma unroll
                for (int i = 0; i < 16; ++i) if (crow(i, hi) > r32) sc[i] = 0.f; }
            lds_cptr vp = (lds_cptr)vimg + vbk * 4096 + ((lane >> 4) & 1) * 32 + (lane & 3) * 8 + (32 * sb + 4 * hi + ((lane & 15) >> 2)) * 64;
            { const bf16x8 pf = PACK8(sc, 0); const s16x4 lo = vtr(vp), h4 = vtr(vp + 512); acc = MFMA32(VFRAG(lo, h4), pf, acc); }
            { const bf16x8 pf = PACK8(sc, 1); const s16x4 lo = vtr(vp + 1024), h4 = vtr(vp + 1024 + 512); acc = MFMA32(VFRAG(lo, h4), pf, acc); }
        }
        float ss = 0.f;
#pragma unroll
        for (int i = 0; i < 16; ++i) ss += acc[i] * acc[i];
        ss += __shfl_xor(ss, 32);
        if (hi == 0) part[vbk * 64 + 32 * tb + r32] = ss;
        __syncthreads();
        const float tss = (part[32 * tb + r32] + part[64 + 32 * tb + r32]) + (part[128 + 32 * tb + r32] + part[192 + 32 * tb + r32]);
        const float rstd = rsqrtf(tss * (1.f / 128.f) + EPS);
        const size_t row = row0 + 32 * tb + r32;
#pragma unroll
        for (int g = 0; g < 4; ++g) { const int v0 = 32 * vbk + 8 * g + 4 * hi; const v2u gg = *(const v2u*)(GG + row * HW + h * 128 + v0); const f32x4 nw = *(const f32x4*)(P.hg_norm_w + v0);
            v2u pk; pk.x = pk2(acc[4 * g] * rstd * nw.x * bflo(gg.x), acc[4 * g + 1] * rstd * nw.y * bfhi(gg.x)); pk.y = pk2(acc[4 * g + 2] * rstd * nw.z * bflo(gg.y), acc[4 * g + 3] * rstd * nw.w * bfhi(gg.y));
            *(v2u*)(MX + row * DM + 512 + h * 128 + v0) = pk; }
        __syncthreads();
    }
}
#endif

__device__ __forceinline__ void phase_mix_a(const Params& P, LAS unsigned char* lds, int vb, int nvb) {
#if FAST_HGRN
    hgrn_pass_a(P, lds, vb, nvb);
#else
    naive_hgrn_rec(P, vb, nvb);
#endif
#if FAST_ATTN
    attn_phase(P, lds, vb, nvb);
#else
    naive_attn(P, lds, vb, nvb);
#endif
}
__device__ __forceinline__ void phase_mix_b(const Params& P, LAS unsigned char* lds, int vb, int nvb) {
#if FAST_HGRN
    hgrn_pass_b(P, vb, nvb);
#else
    naive_hgrn_norm(P, vb, nvb);
#endif
}
__device__ __forceinline__ void phase_mix_c(const Params& P, LAS unsigned char* lds, int vb, int nvb) {
#if FAST_HGRN
    hgrn_pass_c(P, lds, vb, nvb);
#endif
}

enum { PH_PREP = 0, PH_FOLD, PH_GEMM1, PH_MIX_A, PH_MIX_B, PH_MIX_C, PH_OUTPROJ, PH_ROUTE, PH_SCATTER, PH_GATEUP, PH_DOWN, PH_FINAL, PH_COUNT };

template <int PH> __device__ __forceinline__ void run_phase(const Params& P, LAS unsigned char* lds, int vb, int bx, int G) {
    if constexpr (PH == PH_PREP) phase_prep(P, lds, vb, G);
    else if constexpr (PH == PH_FOLD) phase_fold(P, lds, vb, G);
    else if constexpr (PH == PH_GEMM1) phase_gemm1(P, lds, bx, G);
    else if constexpr (PH == PH_MIX_A) phase_mix_a(P, lds, vb, G);
    else if constexpr (PH == PH_MIX_B) phase_mix_b(P, lds, vb, G);
    else if constexpr (PH == PH_MIX_C) phase_mix_c(P, lds, vb, G);
    else if constexpr (PH == PH_OUTPROJ) phase_outproj(P, lds, bx, G);
    else if constexpr (PH == PH_ROUTE) phase_route(P, vb, G);
    else if constexpr (PH == PH_SCATTER) phase_scatter(P, lds, vb, G);
    else if constexpr (PH == PH_GATEUP) phase_gateup(P, lds, bx, G);
    else if constexpr (PH == PH_DOWN) phase_down(P, lds, bx, G);
    else if constexpr (PH == PH_FINAL) phase_final(P, vb, G);
}
#define VB_OF(G, bx) (((G) % 8 == 0) ? ((bx) % 8) * ((G) / 8) + (bx) / 8 : (bx))
#if ONE_LAUNCH
__global__ void __launch_bounds__(NTHR, 2) hymba_fwd(Params P) {
    extern __shared__ __attribute__((aligned(16))) unsigned char lds_raw[];
    LAS unsigned char* lds = (LAS unsigned char*)lds_raw;
    const int G = gridDim.x, bx = blockIdx.x, vb = VB_OF(G, bx);
    cg::grid_group grid = cg::this_grid();
#define RUN(PH) do { if constexpr ((PHASE_MASK >> PH) & 1) run_phase<PH>(P, lds, vb, bx, G); if (PH + 1 < PH_COUNT) grid.sync(); } while (0)
    RUN(0); RUN(1); RUN(2); RUN(3); RUN(4); RUN(5); RUN(6); RUN(7); RUN(8); RUN(9); RUN(10); RUN(11);
#undef RUN
}
#else
template <int PH> __global__ void __launch_bounds__(NTHR, 2) k_phase(Params P) {
    extern __shared__ __attribute__((aligned(16))) unsigned char lds_raw[];
    LAS unsigned char* lds = (LAS unsigned char*)lds_raw;
    const int G = gridDim.x, bx = blockIdx.x, vb = VB_OF(G, bx);
    run_phase<PH>(P, lds, vb, bx, G);
}
template <int PH> static bool launch_phase(const Params& p, int grid, hipStream_t stream) {
    static bool attr = false;
    if (!attr) { if (hipFuncSetAttribute((const void*)k_phase<PH>, hipFuncAttributeMaxDynamicSharedMemorySize, LDS_BYTES) != hipSuccess) { fprintf(stderr, "hipFuncSetAttribute failed (phase %d)\n", PH); return false; } attr = true; }
    hipLaunchKernelGGL(k_phase<PH>, dim3(grid), dim3(NTHR), LDS_BYTES, stream, p);
    return true;
}
#endif

extern "C" void kernel_launch(void* const* d_in, const int* in_sizes, int n_in, void* d_out, int out_size, void* d_ws, size_t ws_size, hipStream_t stream) {
    static int grid = 0;
    if (grid == 0) {
        if (n_in != 24 || out_size != T * DM || ws_size < WS_END) { fprintf(stderr, "kernel_launch: unexpected shapes (n_in %d out %d ws %zu)\n", n_in, out_size, ws_size); grid = -1; return; }
        int dev = 0, cus = 0;
        if (hipGetDevice(&dev) != hipSuccess || hipDeviceGetAttribute(&cus, hipDeviceAttributeMultiprocessorCount, dev) != hipSuccess) { grid = -1; return; }
#if ONE_LAUNCH
        int per_cu = 0;
        if (hipFuncSetAttribute((const void*)hymba_fwd, hipFuncAttributeMaxDynamicSharedMemorySize, LDS_BYTES) != hipSuccess) { fprintf(stderr, "kernel_launch: hipFuncSetAttribute failed\n"); grid = -1; return; }
        if (hipOccupancyMaxActiveBlocksPerMultiprocessor(&per_cu, (const void*)hymba_fwd, NTHR, LDS_BYTES) != hipSuccess || per_cu < 1) { fprintf(stderr, "kernel_launch: occupancy query says %d blocks per CU\n", per_cu); grid = -1; return; }
#endif
        grid = cus;
        (void)hipGetLastError();
    }
    if (grid < 0) return;
    (void)hipMemsetAsync((char*)d_ws + WS_CTL, 0, CTL_ZERO_BYTES, stream);
    Params p{};
    p.x = (const float*)d_in[0]; p.c = (const float*)d_in[1]; p.positions = (const int*)d_in[2]; p.norm1_w = (const float*)d_in[3]; p.norm2_w = (const float*)d_in[4];
    p.final_norm_w = (const float*)d_in[5]; p.ada_w = (const float*)d_in[6]; p.ada_b = (const float*)d_in[7]; p.w_in = (const float*)d_in[8]; p.w_out = (const float*)d_in[9];
    p.lq1 = (const float*)d_in[10]; p.lk1 = (const float*)d_in[11]; p.lq2 = (const float*)d_in[12]; p.lk2 = (const float*)d_in[13]; p.subln_w = (const float*)d_in[14];
    p.hg_lb = (const float*)d_in[15]; p.hg_norm_w = (const float*)d_in[16]; p.w_group = (const float*)d_in[17]; p.b_group = (const float*)d_in[18];
    p.w_router = (const float*)d_in[19]; p.b_router = (const float*)d_in[20]; p.w_gate = (const float*)d_in[21]; p.w_up = (const float*)d_in[22]; p.w_down = (const float*)d_in[23];
    p.out = (float*)d_out; p.ws = (unsigned char*)d_ws; p.ph_lo = 0; p.ph_hi = PH_COUNT;
#if ONE_LAUNCH
    void* args[] = {&p};
    hipError_t e = hipLaunchCooperativeKernel((const void*)hymba_fwd, dim3(grid), dim3(NTHR), args, LDS_BYTES, stream);
    if (e != hipSuccess) fprintf(stderr, "cooperative launch failed: %s (grid %d)\n", hipGetErrorString(e), grid);
#else
    launch_phase<0>(p, grid, stream); launch_phase<1>(p, grid, stream); launch_phase<2>(p, grid, stream); launch_phase<3>(p, grid, stream);
    launch_phase<4>(p, grid, stream); launch_phase<5>(p, grid, stream); launch_phase<6>(p, grid, stream); launch_phase<7>(p, grid, stream);
    launch_phase<8>(p, grid, stream); launch_phase<9>(p, grid, stream); launch_phase<10>(p, grid, stream); launch_phase<11>(p, grid, stream);
#endif
}
```

```cpp
#include <hip/hip_runtime.h>
#include <hip/hip_cooperative_groups.h>
#include <cstdio>
#include <cstdint>
#include <cmath>
namespace cg = cooperative_groups;

namespace pg8 {
#define PG8_LAS __attribute__((address_space(3)))
typedef unsigned short bf16_t;
typedef short bf16x8 __attribute__((ext_vector_type(8)));
typedef float f32x4 __attribute__((ext_vector_type(4)));
typedef unsigned u32x4 __attribute__((ext_vector_type(4)));
constexpr int BM = 256, BK = 64, HALF = 128, HTB = HALF * BK * 2  , STAGE_BYTES = 8 * HTB, NXCD = 8, WGM = 8;

__host__ __device__ __forceinline__ int lds_byte(int r, int c) { const int st = (r >> 4) * 2 + (c >> 5), rr = r & 15, cc = c & 31, ob = rr * 64 + cc * 2; return st * 1024 + (ob ^ (((ob >> 9) & 1) << 5)); }
__host__ __device__ __forceinline__ void stage_rc(int b, int& R, int& C) { const int st = b / 1024, sb = b % 1024, swz = sb ^ (((sb >> 9) & 1) << 5); R = (st >> 1) * 16 + swz / 64; C = (st & 1) * 32 + (swz % 64) / 2; }
__host__ __device__ __forceinline__ int perm32(int rho) { const int n = rho >> 4, i = rho & 15; return 8 * (i >> 2) + 4 * n + (i & 3); }

struct Unit { int pm, pn; };
struct Gemm { const bf16_t* A; const bf16_t* Bt; int M, N, K; };

struct StaticOrder {
    int nM, nN, nwg, G, c;
    __host__ __device__ void init(int M, int N, int G_, int c_) { nM = M / BM; nN = N / BM; nwg = nM * nN; G = G_; c = c_; }
    __host__ __device__ bool next(int i, Unit& u) const {
        const long L = (long)i * G + c; if (L >= nwg) return false;
        int wgid = (int)L; { const int q = nwg / NXCD, r = nwg % NXCD, xcd = wgid % NXCD, off = wgid / NXCD; wgid = (xcd < r ? xcd * (q + 1) : r * (q + 1) + (xcd - r) * q) + off; }
        const int nig = WGM * nN, gid = wgid / nig, fm = gid * WGM, gsz = (nM - fm) < WGM ? (nM - fm) : WGM;
        u.pm = fm + ((wgid % nig) % gsz); u.pn = (wgid % nig) / gsz; return true;
    }
    __device__ __forceinline__ void a_ready(const Unit&) const {}
    __device__ __forceinline__ void done(const Unit&) const {}
};


__device__ __forceinline__ unsigned cvt_pk_bf16(float lo, float hi) { unsigned r; asm volatile("v_cvt_pk_bf16_f32 %0, %1, %2" : "=v"(r) : "v"(lo), "v"(hi)); return r; }
typedef float f32x2 __attribute__((ext_vector_type(2)));

template <class Epi, class Sched, bool ALIGN_EPI = false, bool SP2 = false>
__device__ __forceinline__ void gemm_phase(PG8_LAS unsigned char* lds, const Gemm g, const Sched& S, const Epi& E) {
    int tid_ = threadIdx.x; asm volatile("" : "+v"(tid_));
    const int tid = tid_, wid = __builtin_amdgcn_readfirstlane(tid >> 6), lane = tid & 63, wr = wid >> 2, wc = wid & 3, fr = lane & 15, fq = lane >> 4;
    const int K = g.K, nt = K / BK;
    unsigned voffA[2], voffB[2];
#pragma unroll
    for (int i = 0; i < 2; ++i) { int R, C; stage_rc(tid * 16 + i * 8192, R, C); const int Rb = Epi::PERM ? ((R & ~31) + perm32(R & 31)) : R;
        voffA[i] = (unsigned)(R * K + C) * 2u; voffB[i] = (unsigned)(Rb * K + C) * 2u; }
    const size_t kstep = (size_t)(BK * 2);
    const size_t hstep = (size_t)HALF * K * 2;
    const size_t tstep = 2 * hstep;
    const unsigned ldsw = (unsigned)wid * 1024u;
    const int aoff = lds_byte(wr * 64 + fr, fq * 8), boff = lds_byte(wc * 32 + fr, fq * 8);
#define PG8_SA(b, h) (((b) * 2 + (h)) * HTB)
#define PG8_SB(b, h) ((4 + (b) * 2 + (h)) * HTB)
#define PG8_STAGE(bufoff, gbase, voff) do { _Pragma("unroll") for (int _i = 0; _i < 2; ++_i) \
        __builtin_amdgcn_global_load_lds((const unsigned*)((const char*)(gbase) + (voff)[_i]), (PG8_LAS unsigned*)(lds + (bufoff) + ldsw + _i * 8192), 16, 0, 0); } while (0)
#define PG8_LDA(dst, b, h) do { _Pragma("unroll") for (int m = 0; m < 4; ++m) _Pragma("unroll") for (int k = 0; k < 2; ++k) dst[m][k] = *(const PG8_LAS bf16x8*)(lds + PG8_SA(b, h) + aoff + m * 2048 + k * 1024); } while (0)
#define PG8_LDB(dst, b, h) do { _Pragma("unroll") for (int n = 0; n < 2; ++n) _Pragma("unroll") for (int k = 0; k < 2; ++k) dst[n][k] = *(const PG8_LAS bf16x8*)(lds + PG8_SB(b, h) + boff + n * 2048 + k * 1024); } while (0)
#define PG8_MMA(ai, bj, At, Bt) do { __builtin_amdgcn_s_setprio(1); _Pragma("unroll") for (int m = 0; m < 4; ++m) _Pragma("unroll") for (int n = 0; n < 2; ++n) _Pragma("unroll") for (int k = 0; k < 2; ++k) \
        acc[ai][bj][m][n] = __builtin_amdgcn_mfma_f32_16x16x32_bf16(Bt[n][k], At[m][k], acc[ai][bj][m][n], 0, 0, 0); __builtin_amdgcn_s_setprio(0); } while (0)
#define PG8_WAIT_V(n) asm volatile("s_waitcnt vmcnt(" #n ")" ::: "memory")
#define PG8_WAIT_L(n) asm volatile("s_waitcnt lgkmcnt(" #n ")" ::: "memory")
#define PG8_BAR __builtin_amdgcn_s_barrier()
#define PG8_SCHED __builtin_amdgcn_sched_barrier(0)
    Unit cur, nxt; int ui = 0;
    if (!S.next(0, cur)) return;
    f32x4 acc[2][2][4][2];
#pragma unroll
    for (int a = 0; a < 2; ++a)
#pragma unroll
        for (int b = 0; b < 2; ++b)
#pragma unroll
            for (int m = 0; m < 4; ++m)
#pragma unroll
                for (int n = 0; n < 2; ++n) acc[a][b][m][n] = (f32x4){0.f, 0.f, 0.f, 0.f};
    bf16x8 At[4][2], B0[2][2], B1[2][2];
    const char* cA = (const char*)g.A + (size_t)cur.pm * tstep; const char* cB = (const char*)g.Bt + (size_t)cur.pn * tstep;
    S.a_ready(cur);
    if constexpr (SP2) {
        PG8_STAGE(PG8_SB(0, 0), cB, voffB); PG8_STAGE(PG8_SB(0, 1), cB + hstep, voffB); PG8_STAGE(PG8_SA(0, 0), cA, voffA); PG8_STAGE(PG8_SA(0, 1), cA + hstep, voffA);
        if (wr == 1) PG8_BAR;
        PG8_WAIT_V(2); PG8_BAR;
        PG8_STAGE(PG8_SB(1, 0), cB + kstep, voffB); PG8_STAGE(PG8_SA(1, 0), cA + kstep, voffA); PG8_STAGE(PG8_SB(1, 1), cB + hstep + kstep, voffB);
        PG8_WAIT_V(6); PG8_BAR;
    } else {
        PG8_STAGE(PG8_SB(0, 0), cB, voffB); PG8_STAGE(PG8_SA(0, 0), cA, voffA); PG8_STAGE(PG8_SB(0, 1), cB + hstep, voffB); PG8_STAGE(PG8_SA(0, 1), cA + hstep, voffA);
        if (wr == 1) PG8_BAR;
        PG8_WAIT_V(4); PG8_BAR;
        PG8_STAGE(PG8_SB(1, 0), cB + kstep, voffB); PG8_STAGE(PG8_SA(1, 0), cA + kstep, voffA); PG8_STAGE(PG8_SB(1, 1), cB + hstep + kstep, voffB);
        PG8_WAIT_V(6); PG8_BAR;
    }
    for (;;) {
        const bool has_next = S.next(ui + 1, nxt);
        const char* nA = has_next ? (const char*)g.A + (size_t)nxt.pm * tstep : cA; const char* nB = has_next ? (const char*)g.Bt + (size_t)nxt.pn * tstep : cB;
        for (int t = 0; t < nt; t += 2) {
            const bool last = (t == nt - 2);
            const char* a1 = cA + (size_t)(t + 1) * kstep;
            const char* a2 = last ? nA : cA + (size_t)(t + 2) * kstep; const char* b2 = last ? nB : cB + (size_t)(t + 2) * kstep;
            const char* a3 = a2 + kstep; const char* b3 = b2 + kstep;
            if (last && has_next) S.a_ready(nxt);
            if constexpr (SP2) {
            PG8_LDB(B0, 0, 0); PG8_LDB(B1, 0, 1); PG8_SCHED; PG8_LDA(At, 0, 0); PG8_STAGE(PG8_SA(1, 1), a1 + hstep, voffA);
            PG8_WAIT_V(8); PG8_WAIT_L(0); PG8_BAR; PG8_MMA(0, 0, At, B0); PG8_MMA(0, 1, At, B1); PG8_BAR; PG8_SCHED;
            PG8_LDA(At, 0, 1); PG8_STAGE(PG8_SB(0, 0), b2, voffB); PG8_STAGE(PG8_SB(0, 1), b2 + hstep, voffB); PG8_STAGE(PG8_SA(0, 0), a2, voffA);
            PG8_WAIT_V(8); PG8_WAIT_L(0); PG8_BAR; PG8_MMA(1, 0, At, B0); PG8_MMA(1, 1, At, B1); PG8_BAR; PG8_SCHED;
            PG8_LDB(B0, 1, 0); PG8_LDB(B1, 1, 1); PG8_SCHED; PG8_LDA(At, 1, 0); PG8_STAGE(PG8_SA(0, 1), a2 + hstep, voffA);
            PG8_WAIT_V(8); PG8_WAIT_L(0); PG8_BAR; PG8_MMA(0, 0, At, B0); PG8_MMA(0, 1, At, B1); PG8_BAR; PG8_SCHED;
            PG8_LDA(At, 1, 1); PG8_STAGE(PG8_SB(1, 0), b3, voffB); PG8_STAGE(PG8_SB(1, 1), b3 + hstep, voffB); PG8_STAGE(PG8_SA(1, 0), a3, voffA);
            PG8_WAIT_V(8); PG8_WAIT_L(0); PG8_BAR; PG8_MMA(1, 0, At, B0); PG8_MMA(1, 1, At, B1); PG8_BAR; PG8_SCHED;
            } else {
            PG8_LDB(B0, 0, 0); PG8_SCHED; PG8_LDA(At, 0, 0); PG8_STAGE(PG8_SA(1, 1), a1 + hstep, voffA);
            PG8_WAIT_L(8); PG8_BAR; PG8_WAIT_L(0); PG8_MMA(0, 0, At, B0); PG8_BAR; PG8_SCHED;
            PG8_LDB(B1, 0, 1); PG8_STAGE(PG8_SB(0, 0), b2, voffB);
            PG8_BAR; PG8_WAIT_L(0); PG8_MMA(0, 1, At, B1); PG8_BAR;
            PG8_LDA(At, 0, 1); PG8_STAGE(PG8_SA(0, 0), a2, voffA);
            PG8_BAR; PG8_WAIT_L(0); PG8_MMA(1, 0, At, B0); PG8_BAR; PG8_SCHED;
            PG8_STAGE(PG8_SB(0, 1), b2 + hstep, voffB);
            PG8_WAIT_V(6); PG8_BAR; PG8_MMA(1, 1, At, B1); PG8_BAR;
            PG8_LDB(B0, 1, 0); PG8_SCHED; PG8_LDA(At, 1, 0); PG8_STAGE(PG8_SA(0, 1), a2 + hstep, voffA);
            PG8_WAIT_L(8); PG8_BAR; PG8_WAIT_L(0); PG8_MMA(0, 0, At, B0); PG8_BAR; PG8_SCHED;
            PG8_LDB(B1, 1, 1); PG8_STAGE(PG8_SB(1, 0), b3, voffB);
            PG8_BAR; PG8_WAIT_L(0); PG8_MMA(0, 1, At, B1); PG8_BAR;
            PG8_LDA(At, 1, 1); PG8_STAGE(PG8_SA(1, 0), a3, voffA);
            PG8_BAR; PG8_WAIT_L(0); PG8_MMA(1, 0, At, B0); PG8_BAR; PG8_SCHED;
            PG8_STAGE(PG8_SB(1, 1), b3 + hstep, voffB);
            PG8_WAIT_V(6); PG8_BAR; PG8_MMA(1, 1, At, B1); PG8_BAR;
            }
        }
        if constexpr (ALIGN_EPI) { if (wr == 0) PG8_BAR; }
        if constexpr (!Epi::AFTER_DRAIN) { E(acc, cur, wr, wc, fr, fq); S.done(cur); }
        if (!has_next) break;
#pragma unroll
        for (int a = 0; a < 2; ++a)
#pragma unroll
            for (int b = 0; b < 2; ++b)
#pragma unroll
                for (int m = 0; m < 4; ++m)
#pragma unroll
                    for (int n = 0; n < 2; ++n) acc[a][b][m][n] = (f32x4){0.f, 0.f, 0.f, 0.f};
        cur = nxt; cA = nA; cB = nB; ++ui;
        if constexpr (ALIGN_EPI) { if (wr == 1) PG8_BAR; }
    }
    PG8_WAIT_V(0);
    if constexpr (!ALIGN_EPI) { if (wr == 0) PG8_BAR; }
    PG8_BAR;
    if constexpr (Epi::AFTER_DRAIN) { E.fused(acc, cur, wr, wc, fr, fq, lds, wid, lane); S.done(cur); }
#undef PG8_SA
#undef PG8_SB
#undef PG8_STAGE
#undef PG8_LDA
#undef PG8_LDB
#undef PG8_MMA
#undef PG8_WAIT_V
#undef PG8_WAIT_L
#undef PG8_BAR
#undef PG8_SCHED
}
}

#ifndef PHASE_MASK
#define PHASE_MASK 0xFFF
#endif
#ifndef ONE_LAUNCH
#define ONE_LAUNCH 1
#endif
#ifndef FAST_GEMM
#define FAST_GEMM 1
#endif
#ifndef FAST_ATTN
#define FAST_ATTN 1
#endif
#ifndef FAST_HGRN
#define FAST_HGRN 1
#endif

#define GAS __attribute__((address_space(1)))
#define LAS __attribute__((address_space(3)))
typedef unsigned short bf16;
typedef unsigned v4u __attribute__((ext_vector_type(4)));
typedef unsigned v2u __attribute__((ext_vector_type(2)));
typedef float f32x4 __attribute__((ext_vector_type(4)));
typedef float f32x2 __attribute__((ext_vector_type(2)));
typedef float f32x16 __attribute__((ext_vector_type(16)));
typedef short bf16x8 __attribute__((ext_vector_type(8)));
typedef short s16x4 __attribute__((ext_vector_type(4)));
#define LDS_WAIT() asm volatile("s_waitcnt lgkmcnt(0)" ::: "memory")
#define VM_WAIT() asm volatile("s_waitcnt vmcnt(0)" ::: "memory")

constexpr int NB = 4, SEQ = 4096, T = NB * SEQ, DM = 1024, INW = 3584, NE = 32, FF = 256, HW = 512  ;
constexpr int NWAVES = 8, NTHR = 512;
constexpr float EPS = 1e-6f;
constexpr float QSCALE = 0.125f * 1.4426950408889634f;
constexpr int XS_ROWS = 40960;

constexpr size_t MiB = 1u << 20;
constexpr size_t WS_CTL = 0, CTL_ZERO_BYTES = 256 * 1024;
constexpr size_t WS_MOD = 1 * MiB;
constexpr size_t WS_BIAS1 = 1 * MiB + 128 * 1024;
constexpr size_t WS_LB = 1 * MiB + 192 * 1024;
constexpr size_t WS_WRT = 1 * MiB + 256 * 1024;
constexpr size_t WS_TOKE = 2 * MiB;
constexpr size_t WS_TOKW = 2 * MiB + 128 * 1024;
constexpr size_t WS_TOKP = 2 * MiB + 256 * 1024;
constexpr size_t WS_ROWINFO = 2 * MiB + 384 * 1024;
constexpr size_t WS_ROWW = 2 * MiB + 576 * 1024;
constexpr size_t WS_WOT = 4 * MiB;
constexpr size_t WS_WB = 6 * MiB;
constexpr size_t WS_XN = 34 * MiB;
constexpr size_t WS_MIXED = WS_XN;
constexpr size_t WS_Y = 6 * MiB;
constexpr size_t WS_WGU = 70 * MiB;
constexpr size_t WS_WD = 102 * MiB;
constexpr size_t WS_Q = 118 * MiB, WS_K = 134 * MiB, WS_V = 150 * MiB, WS_GQ = 166 * MiB, WS_GI = 182 * MiB, WS_GG = 198 * MiB;
constexpr size_t WS_LF = 214 * MiB;
constexpr size_t WS_H2 = 118 * MiB;
constexpr size_t WS_XS = 150 * MiB;
constexpr size_t WS_HM = 230 * MiB;
constexpr size_t WS_END = 256 * MiB;
static_assert(WS_LF + (size_t)T * HW * 4 <= WS_END && WS_HM + (size_t)XS_ROWS * FF * 2 <= WS_END && WS_XS + (size_t)XS_ROWS * DM * 2 <= WS_HM && WS_Y + (size_t)T * 2 * DM * 2 <= WS_WGU, "ws map");
constexpr size_t DO_U = 0, DO_D = 32 * MiB, DO_ONAIVE = 0;
constexpr int CW_CNT = 1024;
constexpr int CW_BAR = 4096;

constexpr int LDS_BYTES = 147456;
constexpr int LDS_CTL_OFF = 131072;
constexpr int LC_TILE_E = 64;
constexpr int LC_NTILES = 60;

struct Params {
    const float* x; const float* c; const int* positions; const float* norm1_w; const float* norm2_w; const float* final_norm_w;
    const float* ada_w; const float* ada_b; const float* w_in; const float* w_out;
    const float* lq1; const float* lk1; const float* lq2; const float* lk2; const float* subln_w;
    const float* hg_lb; const float* hg_norm_w; const float* w_group; const float* b_group; const float* w_router; const float* b_router;
    const float* w_gate; const float* w_up; const float* w_down;
    float* out; unsigned char* ws; int ph_lo, ph_hi;
};

__device__ __forceinline__ unsigned f2bf(float f) { unsigned u = __builtin_bit_cast(unsigned, f); return (u + 0x7fffu + ((u >> 16) & 1u)) >> 16; }
__device__ __forceinline__ unsigned pk2(float lo, float hi) { return f2bf(lo) | (f2bf(hi) << 16); }
__device__ __forceinline__ float bf2f(unsigned short h) { return __builtin_bit_cast(float, (unsigned)h << 16); }
__device__ __forceinline__ float bflo(unsigned w) { return __builtin_bit_cast(float, w << 16); }
__device__ __forceinline__ float bfhi(unsigned w) { return __builtin_bit_cast(float, w & 0xffff0000u); }
__device__ __forceinline__ float wave_sum(float v) {
#pragma unroll
    for (int o = 1; o < 64; o <<= 1) v += __shfl_xor(v, o);
    return v;
}
__device__ __forceinline__ float wave_max(float v) {
#pragma unroll
    for (int o = 1; o < 64; o <<= 1) v = fmaxf(v, __shfl_xor(v, o));
    return v;
}
__device__ __forceinline__ float silu_f(float v) { return v / (1.f + __expf(-v)); }
__device__ __forceinline__ float sigmoid_f(float v) { return 1.f / (1.f + __expf(-v)); }

__device__ __forceinline__ void tile_load(const float* W, int N, int k0, int n0, LAS float* scr, int lane) {
#pragma unroll 8
    for (int i = 0; i < 32; ++i) { const int kk = 2 * i + (lane >> 5); scr[kk * 33 + (lane & 31)] = W[(size_t)(k0 + kk) * N + n0 + (lane & 31)]; }
    LDS_WAIT(); asm volatile("" ::: "memory");
}
__device__ __forceinline__ void tile_store(const LAS float* scr, bf16* drow0, int K, int k0, int lane, const float* sc) {
    const int c = lane & 7;
#pragma unroll
    for (int j = 0; j < 4; ++j) { const int n = (lane >> 3) + 8 * j; const LAS float* s = scr + (8 * c) * 33 + n;
        v4u o;
        if (sc) { o.x = pk2(s[0 * 33] * sc[0], s[1 * 33] * sc[1]); o.y = pk2(s[2 * 33] * sc[2], s[3 * 33] * sc[3]); o.z = pk2(s[4 * 33] * sc[4], s[5 * 33] * sc[5]); o.w = pk2(s[6 * 33] * sc[6], s[7 * 33] * sc[7]); }
        else { o.x = pk2(s[0 * 33], s[1 * 33]); o.y = pk2(s[2 * 33], s[3 * 33]); o.z = pk2(s[4 * 33], s[5 * 33]); o.w = pk2(s[6 * 33], s[7 * 33]); }
        *(v4u*)(drow0 + (size_t)n * K + k0 + 8 * c) = o; }
}

__device__ __forceinline__ void phase_prep(const Params& P, LAS unsigned char* lds, int vb, int nvb) {
    const int tid = threadIdx.x, lane = tid & 63, wave = tid >> 6;
    unsigned char* ws = P.ws;
    {
        LAS float* cact = (LAS float*)lds;
        LAS float* part = (LAS float*)(lds + 16384);
        bool have = false;
        for (int it = vb; it < 192; it += nvb) {
            if (!have) { for (int i = tid; i < 4096; i += NTHR) cact[i] = silu_f(P.c[i]); have = true; }
            __syncthreads();
            const int cg_ = tid & 7, rg = tid >> 3, e0 = it * 32 + cg_ * 4;
            float acc[4][4];
#pragma unroll
            for (int b = 0; b < 4; ++b)
#pragma unroll
                for (int j = 0; j < 4; ++j) acc[b][j] = 0.f;
#pragma unroll 4
            for (int i = 0; i < 16; ++i) { const int d = rg + 64 * i; const f32x4 w = *(const f32x4*)(P.ada_w + (size_t)d * 6144 + e0);
#pragma unroll
                for (int b = 0; b < 4; ++b) { const float cv = cact[b * 1024 + d]; acc[b][0] += cv * w.x; acc[b][1] += cv * w.y; acc[b][2] += cv * w.z; acc[b][3] += cv * w.w; } }
#pragma unroll
            for (int b = 0; b < 4; ++b)
#pragma unroll
                for (int j = 0; j < 4; ++j) part[(rg * 8 + cg_) * 16 + b * 4 + j] = acc[b][j];
            __syncthreads();
            if (tid < 128) { const int cgi = tid >> 4, bj = tid & 15; float s = 0.f;
                for (int r = 0; r < 64; ++r) s += part[(r * 8 + cgi) * 16 + bj];
                const int b = bj >> 2, e = it * 32 + cgi * 4 + (bj & 3);
                ((float*)(ws + WS_MOD))[b * 6144 + e] = s + P.ada_b[e]; }
            __syncthreads();
        }
    }
    __syncthreads();
    const int gw = vb * NWAVES + wave, NGW = nvb * NWAVES;
    for (int m = gw; m < T; m += NGW) {
        const f32x4* xr = (const f32x4*)(P.x + (size_t)m * DM) + lane;
        f32x4 v[4]; float s = 0.f;
#pragma unroll
        for (int j = 0; j < 4; ++j) { v[j] = xr[64 * j]; s += (v[j].x * v[j].x + v[j].y * v[j].y) + (v[j].z * v[j].z + v[j].w * v[j].w); }
        const float rstd = rsqrtf(wave_sum(s) * (1.f / DM) + EPS);
        unsigned long long* o8 = (unsigned long long*)((bf16*)(ws + WS_XN) + (size_t)m * DM) + lane;
#pragma unroll
        for (int j = 0; j < 4; ++j) o8[64 * j] = (unsigned long long)pk2(v[j].x * rstd, v[j].y * rstd) | ((unsigned long long)pk2(v[j].z * rstd, v[j].w * rstd) << 32);
    }
    {
        LAS float* scr = (LAS float*)(lds + wave * 16384);
        constexpr int I_WO = 16 * 32, I_G = 16 * 8, I_D = 4 * 32;
        constexpr int NIT = I_WO + NE * I_G * 2 + NE * I_D;
        for (int it = gw; it < NIT; it += NGW) {
            int r = it;
            if (r < I_WO) { const int kb = r / 32, nb = r % 32; tile_load(P.w_out, DM, kb * 64, nb * 32, scr, lane);
                tile_store(scr, (bf16*)(ws + WS_WOT) + (size_t)(nb * 32) * DM, DM, kb * 64, lane, nullptr); LDS_WAIT(); asm volatile("" ::: "memory"); continue; }
            r -= I_WO;
            if (r < NE * I_G * 2) { const int gu = r / (NE * I_G), rr = r % (NE * I_G), e = rr / I_G, q = rr % I_G, kb = q / 8, nb = q % 8;
                const float* W = (gu ? P.w_up : P.w_gate) + (size_t)e * DM * FF; const int f0 = nb * 32;
                tile_load(W, FF, kb * 64, f0, scr, lane);
                const int row0 = 256 * (f0 >> 7) + 128 * gu + (f0 & 127);
                tile_store(scr, (bf16*)(ws + WS_WGU) + ((size_t)e * 512 + row0) * DM, DM, kb * 64, lane, nullptr); LDS_WAIT(); asm volatile("" ::: "memory"); continue; }
            r -= NE * I_G * 2;
            { const int e = r / I_D, q = r % I_D, kb = q / 32, nb = q % 32;
                tile_load(P.w_down + (size_t)e * FF * DM, DM, kb * 64, nb * 32, scr, lane);
                tile_store(scr, (bf16*)(ws + WS_WD) + ((size_t)e * DM + nb * 32) * FF, FF, kb * 64, lane, nullptr); LDS_WAIT(); asm volatile("" ::: "memory"); }
        }
    }
    for (int i = vb * NTHR + tid; i < 512 + 36 * 1024; i += nvb * NTHR) {
        if (i < 512) { const float a0 = P.hg_lb[i], a1 = P.hg_lb[512 + i]; ((float*)(ws + WS_LB))[i] = 1.f / (1.f + __expf(a1 - a0)); }
        else { const int q = i - 512, j = q >> 10, d = q & 1023; ((float*)(ws + WS_WRT))[q] = j < 4 ? P.w_group[d * 4 + j] : P.w_router[d * 32 + (j - 4)]; }
    }
}

__device__ __forceinline__ void phase_fold(const Params& P, LAS unsigned char* lds, int vb, int nvb) {
    const int tid = threadIdx.x, lane = tid & 63, wave = tid >> 6;
    unsigned char* ws = P.ws; const float* mod = (const float*)(ws + WS_MOD);
    const int gw = vb * NWAVES + wave, NGW = nvb * NWAVES;
    LAS float* scr = (LAS float*)(lds + wave * 16384);
    for (int it = gw; it < 16 * 112; it += NGW) {
        const int kb = it / 112, nb = it % 112, k0 = kb * 64, n0 = nb * 32;
        tile_load(P.w_in, INW, k0, n0, scr, lane);
        const int c = lane & 7;
#pragma unroll 1
        for (int b = 0; b < 4; ++b) { float sc[8];
#pragma unroll
            for (int j = 0; j < 8; ++j) { const int k = k0 + 8 * c + j; sc[j] = P.norm1_w[k] * (1.f + mod[b * 6144 + 1024 + k]); }
            tile_store(scr, (bf16*)(ws + WS_WB) + ((size_t)b * INW + n0) * DM, DM, k0, lane, sc); }
        LDS_WAIT(); asm volatile("" ::: "memory");
    }
    __syncthreads();
    LAS float* red = (LAS float*)lds;
    for (int it = vb; it < 56; it += nvb) {
        const int n = it * 64 + lane; float a[4] = {0.f, 0.f, 0.f, 0.f};
#pragma unroll 8
        for (int i = 0; i < 128; ++i) { const int k = wave * 128 + i; const float w = P.w_in[(size_t)k * INW + n];
#pragma unroll
            for (int b = 0; b < 4; ++b) a[b] += mod[b * 6144 + k] * w; }
#pragma unroll
        for (int b = 0; b < 4; ++b) red[(wave * 4 + b) * 64 + lane] = a[b];
        __syncthreads();
        if (tid < 256) { const int b = tid >> 6; float s = 0.f;
#pragma unroll
            for (int w8 = 0; w8 < 8; ++w8) s += red[(w8 * 4 + b) * 64 + lane];
            ((float*)(ws + WS_BIAS1))[b * INW + n] = s; }
        __syncthreads();
    }
}

__device__ __forceinline__ void proj_finish(const Params& P, int r, int c0, float* v, const float* pv) {
    unsigned char* ws = P.ws;
    const int b = r >> 12, region = c0 >> 9, cc = c0 & 511;
    const float* bias = (const float*)(ws + WS_BIAS1) + b * INW;
    {   const f32x4 b0 = *(const f32x4*)(bias + c0), b1 = *(const f32x4*)(bias + c0 + 4);
        v[0] += b0.x; v[1] += b0.y; v[2] += b0.z; v[3] += b0.w; v[4] += b1.x; v[5] += b1.y; v[6] += b1.z; v[7] += b1.w; }
    if (region < 2) {
        const int d0 = c0 & 63;
        if (d0 < 16) {
            const f32x4 q0 = *(const f32x4*)(bias + (c0 ^ 8)), q1 = *(const f32x4*)(bias + (c0 ^ 8) + 4);
            const float pb[8] = {q0.x, q0.y, q0.z, q0.w, q1.x, q1.y, q1.z, q1.w};
            const float pos = (float)P.positions[r];
            const float invf[8] = {1.0f, 0.19392274474868576f, 0.03760603093086393f, 0.007292664737217109f, 0.001414213562373095f, 0.0002742481756762073f, 5.318295896944988e-05f, 1.031338537721246e-05f};
            const float sgn = d0 < 8 ? -1.f : 1.f;
#pragma unroll
            for (int j = 0; j < 8; ++j) { const float ang = pos * invf[j]; float rev = ang * 0.15915494309189535f; rev = rev - floorf(rev);
                const float sn = __builtin_amdgcn_sinf(rev), cs = __builtin_amdgcn_cosf(rev);
                v[j] = v[j] * cs + sgn * (pv[j] + pb[j]) * sn; }
        }
        const float sc = region == 0 ? QSCALE : 1.f;
        v4u o; o.x = pk2(v[0] * sc, v[1] * sc); o.y = pk2(v[2] * sc, v[3] * sc); o.z = pk2(v[4] * sc, v[5] * sc); o.w = pk2(v[6] * sc, v[7] * sc);
        *(v4u*)((bf16*)(ws + (region == 0 ? WS_Q : WS_K)) + (size_t)r * HW + cc) = o;
    } else if (region == 4) {
        const float* lb = (const float*)(ws + WS_LB) + cc; float o[8];
#pragma unroll
        for (int j = 0; j < 8; ++j) { const float l = lb[j]; o[j] = __logf(l + (1.f - l) * sigmoid_f(v[j])); }
        float* dst = (float*)(ws + WS_LF) + (size_t)r * HW + cc;
        *(f32x4*)dst = (f32x4){o[0], o[1], o[2], o[3]}; *(f32x4*)(dst + 4) = (f32x4){o[4], o[5], o[6], o[7]};
    } else {
        if (region == 3 || region == 6) {
#pragma unroll
            for (int j = 0; j < 8; ++j) v[j] = silu_f(v[j]); }
        const size_t off = region == 2 ? WS_V : region == 3 ? WS_GQ : region == 5 ? WS_GI : WS_GG;
        v4u o; o.x = pk2(v[0], v[1]); o.y = pk2(v[2], v[3]); o.z = pk2(v[4], v[5]); o.w = pk2(v[6], v[7]);
        *(v4u*)((bf16*)(ws + off) + (size_t)r * HW + cc) = o;
    }
}
__device__ __forceinline__ void outproj_finish(const Params& P, int r, int c0, const float* v) {
    const int b = r >> 12; const float* g1 = (const float*)(P.ws + WS_MOD) + b * 6144 + 2048 + c0;
    const float* xr = P.x + (size_t)r * DM + c0; float* o = P.out + (size_t)r * DM + c0;
    const f32x4 x0 = *(const f32x4*)xr, x1 = *(const f32x4*)(xr + 4), g0 = *(const f32x4*)g1, g4 = *(const f32x4*)(g1 + 4);
    *(f32x4*)o = (f32x4){x0.x + g0.x * v[0], x0.y + g0.y * v[1], x0.z + g0.z * v[2], x0.w + g0.w * v[3]};
    *(f32x4*)(o + 4) = (f32x4){x1.x + g4.x * v[4], x1.y + g4.y * v[5], x1.z + g4.z * v[6], x1.w + g4.w * v[7]};
}
__device__ __forceinline__ void gateup_finish(const Params& P, int rs, int f0, const float* g, const float* u) {
    const float w = ((const float*)(P.ws + WS_ROWW))[rs]; float h[8];
#pragma unroll
    for (int j = 0; j < 8; ++j) h[j] = silu_f(g[j]) * u[j] * w;
    v4u o; o.x = pk2(h[0], h[1]); o.y = pk2(h[2], h[3]); o.z = pk2(h[4], h[5]); o.w = pk2(h[6], h[7]);
    *(v4u*)((bf16*)(P.ws + WS_HM) + (size_t)rs * FF + f0) = o;
}
__device__ __forceinline__ void down_finish(const Params& P, int rs, int c0, const float* v) {
    const int dest = ((const int*)(P.ws + WS_ROWINFO))[rs];
    if (dest >= 0) { v4u o; o.x = pk2(v[0], v[1]); o.y = pk2(v[2], v[3]); o.z = pk2(v[4], v[5]); o.w = pk2(v[6], v[7]);
        *(v4u*)((bf16*)(P.ws + WS_Y) + (size_t)dest * DM + c0) = o; }
}

template <class BRow, class Fin>
__device__ __forceinline__ void naive_gemm(const bf16* A, int M, int N, int K, const BRow& brow, const Fin& fin, int vb, int nvb) {
    const long total = (long)M * (N / 16);
    for (long i = (long)vb * NTHR + threadIdx.x; i < total; i += (long)nvb * NTHR) {
        const int r = (int)(i / (N / 16)), c16 = (int)(i % (N / 16)) * 16;
        float acc[16];
#pragma unroll
        for (int j = 0; j < 16; ++j) acc[j] = 0.f;
        const bf16* a = A + (size_t)r * K;
        for (int k = 0; k < K; k += 8) {
            const v4u av = *(const v4u*)(a + k);
            const float af[8] = {bflo(av.x), bfhi(av.x), bflo(av.y), bfhi(av.y), bflo(av.z), bfhi(av.z), bflo(av.w), bfhi(av.w)};
#pragma unroll
            for (int j = 0; j < 16; ++j) { const v4u bv = *(const v4u*)(brow(r, c16 + j) + k);
                acc[j] += af[0] * bflo(bv.x) + af[1] * bfhi(bv.x) + af[2] * bflo(bv.y) + af[3] * bfhi(bv.y) + af[4] * bflo(bv.z) + af[5] * bfhi(bv.z) + af[6] * bflo(bv.w) + af[7] * bfhi(bv.w); }
        }
        fin(r, c16, acc);
    }
}

struct EpiProj {
    static constexpr bool PERM = true, AFTER_DRAIN = false;
    Params P;
    __device__ __forceinline__ void operator()(const pg8::f32x4 (&acc)[2][2][4][2], const pg8::Unit& u, int wr, int wc, int fr, int fq) const {
        const int pnl = u.pn % 14; const bool rot = (pnl < 4) && !(wc & 1);
#pragma unroll
        for (int ai = 0; ai < 2; ++ai)
#pragma unroll
            for (int m = 0; m < 4; ++m) { const int r = u.pm * 256 + ai * 128 + wr * 64 + m * 16 + fr;
#pragma unroll
                for (int bj = 0; bj < 2; ++bj) { const int c0 = pnl * 256 + bj * 128 + wc * 32 + 8 * fq;
                    float v[8], pv[8];
#pragma unroll
                    for (int n = 0; n < 2; ++n)
#pragma unroll
                        for (int j = 0; j < 4; ++j) v[n * 4 + j] = acc[ai][bj][m][n][j];
                    if (rot) {
#pragma unroll
                        for (int j = 0; j < 8; ++j) pv[j] = __shfl_xor(v[j], 16); }
                    else {
#pragma unroll
                        for (int j = 0; j < 8; ++j) pv[j] = 0.f; }
                    proj_finish(P, r, c0, v, pv); } }
    }
};
struct EpiOut {
    static constexpr bool PERM = true, AFTER_DRAIN = false;
    Params P;
    __device__ __forceinline__ void operator()(const pg8::f32x4 (&acc)[2][2][4][2], const pg8::Unit& u, int wr, int wc, int fr, int fq) const {
#pragma unroll
        for (int ai = 0; ai < 2; ++ai)
#pragma unroll
            for (int m = 0; m < 4; ++m) { const int r = u.pm * 256 + ai * 128 + wr * 64 + m * 16 + fr;
#pragma unroll
                for (int bj = 0; bj < 2; ++bj) { const int c0 = u.pn * 256 + bj * 128 + wc * 32 + 8 * fq; float v[8];
#pragma unroll
                    for (int n = 0; n < 2; ++n)
#pragma unroll
                        for (int j = 0; j < 4; ++j) v[n * 4 + j] = acc[ai][bj][m][n][j];
                    outproj_finish(P, r, c0, v); } }
    }
};
struct EpiGateUp {
    static constexpr bool PERM = true, AFTER_DRAIN = false;
    Params P;
    __device__ __forceinline__ void operator()(const pg8::f32x4 (&acc)[2][2][4][2], const pg8::Unit& u, int wr, int wc, int fr, int fq) const {
        const int pnl = u.pn & 1;
#pragma unroll
        for (int ai = 0; ai < 2; ++ai)
#pragma unroll
            for (int m = 0; m < 4; ++m) { const int rs = u.pm * 256 + ai * 128 + wr * 64 + m * 16 + fr; float g[8], up[8];
#pragma unroll
                for (int n = 0; n < 2; ++n)
#pragma unroll
                    for (int j = 0; j < 4; ++j) { g[n * 4 + j] = acc[ai][0][m][n][j]; up[n * 4 + j] = acc[ai][1][m][n][j]; }
                gateup_finish(P, rs, pnl * 128 + wc * 32 + 8 * fq, g, up); }
    }
};
struct EpiDown {
    static constexpr bool PERM = true, AFTER_DRAIN = false;
    Params P;
    __device__ __forceinline__ void operator()(const pg8::f32x4 (&acc)[2][2][4][2], const pg8::Unit& u, int wr, int wc, int fr, int fq) const {
        const int pnl = u.pn & 3;
#pragma unroll
        for (int ai = 0; ai < 2; ++ai)
#pragma unroll
            for (int m = 0; m < 4; ++m) { const int rs = u.pm * 256 + ai * 128 + wr * 64 + m * 16 + fr;
#pragma unroll
                for (int bj = 0; bj < 2; ++bj) { const int c0 = pnl * 256 + bj * 128 + wc * 32 + 8 * fq; float v[8];
#pragma unroll
                    for (int n = 0; n < 2; ++n)
#pragma unroll
                        for (int j = 0; j < 4; ++j) v[n * 4 + j] = acc[ai][bj][m][n][j];
                    down_finish(P, rs, c0, v); }
                asm volatile("" ::: "memory"); }
    }
};
struct BatchOrder {
    pg8::StaticOrder so;
    __device__ bool next(int i, pg8::Unit& u) const { if (!so.next(i, u)) return false; u.pn += (u.pm >> 4) * 14; return true; }
    __device__ __forceinline__ void a_ready(const pg8::Unit&) const {}
    __device__ __forceinline__ void done(const pg8::Unit&) const {}
};
struct GroupOrder {
    const LAS int* tile_e; int ntiles, NTN, G, c;
    __device__ bool next(int i, pg8::Unit& u) const {
        const int L = i * G + c; if (L >= ntiles * NTN) return false;
        const int rt = L / NTN, j = L % NTN; const int e = __builtin_amdgcn_readfirstlane(tile_e[rt]);
        u.pm = rt; u.pn = e * NTN + j; return true; }
    __device__ __forceinline__ void a_ready(const pg8::Unit&) const {}
    __device__ __forceinline__ void done(const pg8::Unit&) const {}
};

__device__ __forceinline__ int build_tiles(const Params& P, LAS unsigned char* lds) {
    LAS int* lc = (LAS int*)(lds + LDS_CTL_OFF);
    __syncthreads();
    if (threadIdx.x == 0) { const int* cnt = (const int*)(P.ws + WS_CTL) + CW_CNT; int t = 0;
        for (int e = 0; e < NE; ++e) { const int n = (__hip_atomic_load(cnt + e, __ATOMIC_RELAXED, __HIP_MEMORY_SCOPE_AGENT) + 255) >> 8; for (int j = 0; j < n; ++j) lc[LC_TILE_E + t + j] = e; t += n; }
        lc[LC_NTILES] = t; }
    __syncthreads();
    return lc[LC_NTILES];
}

__device__ __forceinline__ void phase_gemm1(const Params& P, LAS unsigned char* lds, int vb, int nvb) {
    unsigned char* ws = P.ws;
#if FAST_GEMM
    pg8::Gemm g{(const bf16*)(ws + WS_XN), (const bf16*)(ws + WS_WB), T, INW, DM}; BatchOrder S; S.so.init(T, INW, nvb, vb);
    EpiProj E{P};
    pg8::gemm_phase<EpiProj, BatchOrder, true, true>(lds, g, S, E);
#else
    const bf16* WB = (const bf16*)(ws + WS_WB);
    naive_gemm((const bf16*)(ws + WS_XN), T, INW, DM,
        [&](int r, int n) { return WB + ((size_t)(r >> 12) * INW + n) * DM; },
        [&](int r, int c16, float* acc) { float pv[8];
#pragma unroll
            for (int j = 0; j < 8; ++j) pv[j] = acc[8 + j];
            float v0[8];
#pragma unroll
            for (int j = 0; j < 8; ++j) v0[j] = acc[j];
            proj_finish(P, r, c16, acc, pv); proj_finish(P, r, c16 + 8, acc + 8, v0); }, vb, nvb);
#endif
}
__device__ __forceinline__ void phase_outproj(const Params& P, LAS unsigned char* lds, int vb, int nvb) {
    unsigned char* ws = P.ws;
#if FAST_GEMM
    pg8::Gemm g{(const bf16*)(ws + WS_MIXED), (const bf16*)(ws + WS_WOT), T, DM, DM}; pg8::StaticOrder S; S.init(T, DM, nvb, vb);
    EpiOut E{P};
    pg8::gemm_phase<EpiOut, pg8::StaticOrder, true, true>(lds, g, S, E);
#else
    const bf16* W = (const bf16*)(ws + WS_WOT);
    naive_gemm((const bf16*)(ws + WS_MIXED), T, DM, DM, [&](int r, int n) { return W + (size_t)n * DM; },
        [&](int r, int c16, float* acc) { outproj_finish(P, r, c16, acc); outproj_finish(P, r, c16 + 8, acc + 8); }, vb, nvb);
#endif
}
__device__ __forceinline__ void phase_gateup(const Params& P, LAS unsigned char* lds, int vb, int nvb) {
    unsigned char* ws = P.ws;
    const int ntiles = build_tiles(P, lds);
#if FAST_GEMM
    pg8::Gemm g{(const bf16*)(ws + WS_XS), (const bf16*)(ws + WS_WGU), XS_ROWS, NE * 512, DM};
    GroupOrder S{(const LAS int*)(lds + LDS_CTL_OFF) + LC_TILE_E, ntiles, 2, nvb, vb};
    EpiGateUp E{P};
    pg8::gemm_phase<EpiGateUp, GroupOrder, true, true>(lds, g, S, E);
#else
    const LAS int* te = (const LAS int*)(lds + LDS_CTL_OFF) + LC_TILE_E; const bf16* W = (const bf16*)(ws + WS_WGU);
    const long total = (long)ntiles * 256 * 16;
    for (long i = (long)vb * NTHR + threadIdx.x; i < total; i += (long)nvb * NTHR) {
        const int rs = (int)(i / 16), f16 = (int)(i % 16) * 16, e = te[rs >> 8];
        float g[16], u[16];
#pragma unroll
        for (int j = 0; j < 16; ++j) { g[j] = 0.f; u[j] = 0.f; }
        const bf16* a = (const bf16*)(ws + WS_XS) + (size_t)rs * DM;
        for (int k = 0; k < DM; k += 8) { const v4u av = *(const v4u*)(a + k);
            const float af[8] = {bflo(av.x), bfhi(av.x), bflo(av.y), bfhi(av.y), bflo(av.z), bfhi(av.z), bflo(av.w), bfhi(av.w)};
#pragma unroll
            for (int j = 0; j < 16; ++j) { const int f = f16 + j; const int rowg = 256 * (f >> 7) + (f & 127);
                const v4u bg = *(const v4u*)(W + ((size_t)e * 512 + rowg) * DM + k), bu = *(const v4u*)(W + ((size_t)e * 512 + rowg + 128) * DM + k);
                g[j] += af[0] * bflo(bg.x) + af[1] * bfhi(bg.x) + af[2] * bflo(bg.y) + af[3] * bfhi(bg.y) + af[4] * bflo(bg.z) + af[5] * bfhi(bg.z) + af[6] * bflo(bg.w) + af[7] * bfhi(bg.w);
                u[j] += af[0] * bflo(bu.x) + af[1] * bfhi(bu.x) + af[2] * bflo(bu.y) + af[3] * bfhi(bu.y) + af[4] * bflo(bu.z) + af[5] * bfhi(bu.z) + af[6] * bflo(bu.w) + af[7] * bfhi(bu.w); } }
        gateup_finish(P, rs, f16, g, u); gateup_finish(P, rs, f16 + 8, g + 8, u + 8);
    }
#endif
}
__device__ __forceinline__ void phase_down(const Params& P, LAS unsigned char* lds, int vb, int nvb) {
    unsigned char* ws = P.ws;
    const int ntiles = build_tiles(P, lds);
#if FAST_GEMM
    pg8::Gemm g{(const bf16*)(ws + WS_HM), (const bf16*)(ws + WS_WD), XS_ROWS, NE * DM, FF + P.ph_lo};
    GroupOrder S{(const LAS int*)(lds + LDS_CTL_OFF) + LC_TILE_E, ntiles, 4, nvb, vb};
    EpiDown E{P};
    pg8::gemm_phase<EpiDown, GroupOrder, true, true>(lds, g, S, E);
#else
    const LAS int* te = (const LAS int*)(lds + LDS_CTL_OFF) + LC_TILE_E; const bf16* W = (const bf16*)(ws + WS_WD);
    naive_gemm((const bf16*)(ws + WS_HM), ntiles * 256, DM, FF, [&](int r, int n) { return W + ((size_t)te[r >> 8] * DM + n) * FF; },
        [&](int r, int c16, float* acc) { down_finish(P, r, c16, acc); down_finish(P, r, c16 + 8, acc + 8); }, vb, nvb);
#endif
}

__device__ __forceinline__ float diff_lambda(const Params& P, int lane) {
    const float s1 = wave_sum(P.lq1[lane] * P.lk1[lane]), s2 = wave_sum(P.lq2[lane] * P.lk2[lane]);
    return __expf(s1) - __expf(s2) + 0.2f;
}
__device__ __forceinline__ void naive_attn(const Params& P, LAS unsigned char* lds, int vb, int nvb) {
    const int tid = threadIdx.x, lane = tid & 63, wave = tid >> 6; unsigned char* ws = P.ws;
    const bf16* Q = (const bf16*)(ws + WS_Q); const bf16* K = (const bf16*)(ws + WS_K); const bf16* V = (const bf16*)(ws + WS_V); bf16* MX = (bf16*)(ws + WS_MIXED);
    LAS float* qs = (LAS float*)(lds + wave * 512);
    const float lam = diff_lambda(P, lane);
    for (int task = vb * NWAVES + wave; task < NB * 4 * SEQ; task += nvb * NWAVES) {
        const int q = task % SEQ, bh = task / SEQ, h = bh & 3, b = bh >> 2; const size_t row = (size_t)b * SEQ + q;
        { const unsigned w = *(const unsigned*)(Q + row * HW + h * 128 + 2 * lane); qs[2 * lane] = bflo(w); qs[2 * lane + 1] = bfhi(w); }
        LDS_WAIT(); asm volatile("" ::: "memory");
        float m0 = -INFINITY, m1 = -INFINITY, l0 = 0.f, l1 = 0.f, o00 = 0.f, o01 = 0.f, o10 = 0.f, o11 = 0.f;
        for (int kc = 0; kc * 64 <= q; ++kc) {
            const int key = kc * 64 + lane; const bool valid = key <= q;
            const bf16* kr = K + ((size_t)b * SEQ + key) * HW + h * 128; float s0 = 0.f, s1 = 0.f;
#pragma unroll
            for (int d = 0; d < 64; d += 8) { const v4u a = *(const v4u*)(kr + d), c2 = *(const v4u*)(kr + 64 + d);
                s0 += qs[d] * bflo(a.x) + qs[d + 1] * bfhi(a.x) + qs[d + 2] * bflo(a.y) + qs[d + 3] * bfhi(a.y) + qs[d + 4] * bflo(a.z) + qs[d + 5] * bfhi(a.z) + qs[d + 6] * bflo(a.w) + qs[d + 7] * bfhi(a.w);
                s1 += qs[64 + d] * bflo(c2.x) + qs[65 + d] * bfhi(c2.x) + qs[66 + d] * bflo(c2.y) + qs[67 + d] * bfhi(c2.y) + qs[68 + d] * bflo(c2.z) + qs[69 + d] * bfhi(c2.z) + qs[70 + d] * bflo(c2.w) + qs[71 + d] * bfhi(c2.w); }
            if (!valid) { s0 = -INFINITY; s1 = -INFINITY; }
            const float n0 = fmaxf(m0, wave_max(s0)), n1 = fmaxf(m1, wave_max(s1));
            const float p0 = valid ? exp2f(s0 - n0) : 0.f, p1 = valid ? exp2f(s1 - n1) : 0.f;
            const float a0 = exp2f(m0 - n0), a1 = exp2f(m1 - n1);
            l0 = l0 * a0 + wave_sum(p0); l1 = l1 * a1 + wave_sum(p1); o00 *= a0; o01 *= a0; o10 *= a1; o11 *= a1; m0 = n0; m1 = n1;
            const bf16* vr = V + ((size_t)b * SEQ + kc * 64) * HW + h * 128 + 2 * lane;
            for (int kk = 0; kk < 64; ++kk) { const float pa = __shfl(p0, kk), pb = __shfl(p1, kk); const unsigned w = *(const unsigned*)(vr + (size_t)kk * HW);
                const float va = bflo(w), vb2 = bfhi(w); o00 += pa * va; o01 += pa * vb2; o10 += pb * va; o11 += pb * vb2; }
        }
        const float r0 = o00 / l0 - lam * o10 / l1, r1 = o01 / l0 - lam * o11 / l1;
        const float rstd = rsqrtf(wave_sum(r0 * r0 + r1 * r1) * (1.f / 128.f) + EPS);
        *(unsigned*)(MX + row * DM + h * 128 + 2 * lane) = pk2(r0 * rstd * P.subln_w[2 * lane] * 0.8f, r1 * rstd * P.subln_w[2 * lane + 1] * 0.8f);
        asm volatile("" ::: "memory");
    }
}
__device__ __forceinline__ void naive_hgrn_rec(const Params& P, int vb, int nvb) {
    const int tid = threadIdx.x; unsigned char* ws = P.ws;
    const bf16* GQ = (const bf16*)(ws + WS_GQ); const bf16* GI = (const bf16*)(ws + WS_GI); const float* LF = (const float*)(ws + WS_LF);
    float* OB = (float*)((unsigned char*)P.out + DO_ONAIVE);
    for (int grp = vb * 4 + (tid >> 7); grp < 16; grp += nvb * 4) {
        const int b = grp >> 2, h = grp & 3, v = tid & 127;
        float S[128];
#pragma unroll
        for (int k = 0; k < 128; ++k) S[k] = 0.f;
        for (int t = 0; t < SEQ; ++t) {
            const size_t base = ((size_t)b * SEQ + t) * HW + h * 128;
            const float vv = bf2f(GI[base + v]); float o = 0.f;
#pragma unroll
            for (int k = 0; k < 128; k += 4) { const f32x4 lf = *(const f32x4*)(LF + base + k); const v2u qw = *(const v2u*)(GQ + base + k);
                const float f0 = __expf(lf.x), f1 = __expf(lf.y), f2 = __expf(lf.z), f3 = __expf(lf.w);
                S[k] = f0 * S[k] + (1.f - f0) * vv; S[k + 1] = f1 * S[k + 1] + (1.f - f1) * vv; S[k + 2] = f2 * S[k + 2] + (1.f - f2) * vv; S[k + 3] = f3 * S[k + 3] + (1.f - f3) * vv;
                o += S[k] * bflo(qw.x) + S[k + 1] * bfhi(qw.x) + S[k + 2] * bflo(qw.y) + S[k + 3] * bfhi(qw.y); }
            OB[base + v] = o;
        }
    }
}
__device__ __forceinline__ void naive_hgrn_norm(const Params& P, int vb, int nvb) {
    const int tid = threadIdx.x, lane = tid & 63, wave = tid >> 6; unsigned char* ws = P.ws;
    const float* OB = (const float*)((unsigned char*)P.out + DO_ONAIVE); const bf16* GG = (const bf16*)(ws + WS_GG); bf16* MX = (bf16*)(ws + WS_MIXED);
    for (int task = vb * NWAVES + wave; task < T * 4; task += nvb * NWAVES) {
        const int row = task >> 2, h = task & 3; const size_t base = (size_t)row * HW + h * 128 + 2 * lane;
        const f32x2 o = *(const f32x2*)(OB + base); const float rstd = rsqrtf(wave_sum(o.x * o.x + o.y * o.y) * (1.f / 128.f) + EPS);
        const unsigned g = *(const unsigned*)(GG + base);
        *(unsigned*)(MX + (size_t)row * DM + 512 + h * 128 + 2 * lane) = pk2(o.x * rstd * P.hg_norm_w[2 * lane] * bflo(g), o.y * rstd * P.hg_norm_w[2 * lane + 1] * bfhi(g));
    }
}

__device__ __forceinline__ void phase_route(const Params& P, int vb, int nvb) {
    const int tid = threadIdx.x, lane = tid & 63, wave = tid >> 6; unsigned char* ws = P.ws;
    const float* mod = (const float*)(ws + WS_MOD); const float* WRT = (const float*)(ws + WS_WRT);
    int* cnt = (int*)(ws + WS_CTL) + CW_CNT;
    for (int t = vb * NWAVES + wave; t < T; t += nvb * NWAVES) {
        const int b = t >> 12;
        const f32x4* xr = (const f32x4*)(P.out + (size_t)t * DM) + lane;
        f32x4 v[4]; float s = 0.f;
#pragma unroll
        for (int j = 0; j < 4; ++j) { v[j] = xr[64 * j]; s += (v[j].x * v[j].x + v[j].y * v[j].y) + (v[j].z * v[j].z + v[j].w * v[j].w); }
        const float rstd = rsqrtf(wave_sum(s) * (1.f / DM) + EPS);
        unsigned long long* o8 = (unsigned long long*)((bf16*)(ws + WS_H2) + (size_t)t * DM) + lane;
#pragma unroll
        for (int j = 0; j < 4; ++j) { const int d = 4 * lane + 256 * j;
            const f32x4 nw = *(const f32x4*)(P.norm2_w + d), sc = *(const f32x4*)(mod + b * 6144 + 4096 + d), sh = *(const f32x4*)(mod + b * 6144 + 3072 + d);
            v[j].x = v[j].x * rstd * nw.x * (1.f + sc.x) + sh.x; v[j].y = v[j].y * rstd * nw.y * (1.f + sc.y) + sh.y;
            v[j].z = v[j].z * rstd * nw.z * (1.f + sc.z) + sh.z; v[j].w = v[j].w * rstd * nw.w * (1.f + sc.w) + sh.w;
            o8[64 * j] = (unsigned long long)pk2(v[j].x, v[j].y) | ((unsigned long long)pk2(v[j].z, v[j].w) << 32); }
        float myL = 0.f;
#pragma unroll 2
        for (int jj = 0; jj < 36; ++jj) { const f32x4* wr_ = (const f32x4*)(WRT + jj * 1024) + lane; float a = 0.f;
#pragma unroll
            for (int j = 0; j < 4; ++j) { const f32x4 w = wr_[64 * j]; a += (v[j].x * w.x + v[j].y * w.y) + (v[j].z * w.z + v[j].w * w.w); }
            a = wave_sum(a); if (lane == jj) myL = a; }
        float L[36];
#pragma unroll
        for (int jj = 0; jj < 36; ++jj) L[jj] = __shfl(myL, jj);
        float gl[4];
#pragma unroll
        for (int i = 0; i < 4; ++i) gl[i] = L[i] + P.b_group[i];
        int g = 0; float gm = gl[0];
#pragma unroll
        for (int i = 1; i < 4; ++i) if (gl[i] > gm) { gm = gl[i]; g = i; }
        float gs = 0.f;
#pragma unroll
        for (int i = 0; i < 4; ++i) gs += __expf(gl[i] - gm);
        const float gw_ = 1.f / gs;
        float el[8];
#pragma unroll
        for (int i = 0; i < 8; ++i) { const float a0 = L[4 + i] + P.b_router[i], a1 = L[12 + i] + P.b_router[8 + i], a2 = L[20 + i] + P.b_router[16 + i], a3 = L[28 + i] + P.b_router[24 + i];
            el[i] = g == 0 ? a0 : g == 1 ? a1 : g == 2 ? a2 : a3; }
        int i1 = 0; float e1 = el[0];
#pragma unroll
        for (int i = 1; i < 8; ++i) if (el[i] > e1) { e1 = el[i]; i1 = i; }
        int i2 = -1; float e2 = -INFINITY;
#pragma unroll
        for (int i = 0; i < 8; ++i) if (i != i1 && el[i] > e2) { e2 = el[i]; i2 = i; }
        const float w1 = 1.f / (1.f + __expf(e2 - e1)), w2 = 1.f - w1;
        if (lane == 0) {
            const int ea = g * 8 + i1, eb = g * 8 + i2;
            const int pa = atomicAdd(cnt + ea, 1), pb = atomicAdd(cnt + eb, 1);
            int* te = (int*)(ws + WS_TOKE) + 2 * t; float* tw = (float*)(ws + WS_TOKW) + 2 * t; int* tp = (int*)(ws + WS_TOKP) + 2 * t;
            te[0] = ea; te[1] = eb; tw[0] = w1 * gw_; tw[1] = w2 * gw_; tp[0] = pa; tp[1] = pb;
        }
    }
}
__device__ __forceinline__ void phase_scatter(const Params& P, LAS unsigned char* lds, int vb, int nvb) {
    const int tid = threadIdx.x, lane = tid & 63, wave = tid >> 6; unsigned char* ws = P.ws;
    LAS int* off = (LAS int*)(lds + LDS_CTL_OFF) + 256;
    __syncthreads();
    if (tid == 0) { const int* cnt = (const int*)(ws + WS_CTL) + CW_CNT; int o = 0;
        for (int e = 0; e < NE; ++e) { const int n = __hip_atomic_load(cnt + e, __ATOMIC_RELAXED, __HIP_MEMORY_SCOPE_AGENT); off[e] = o; off[40 + e] = n; o += ((n + 255) >> 8) << 8; }
        off[32] = o; }
    __syncthreads();
    int* rinfo = (int*)(ws + WS_ROWINFO); float* roww = (float*)(ws + WS_ROWW); bf16* XS = (bf16*)(ws + WS_XS);
    for (int t = vb * NWAVES + wave; t < T; t += nvb * NWAVES) {
        const int* te = (const int*)(ws + WS_TOKE) + 2 * t; const float* tw = (const float*)(ws + WS_TOKW) + 2 * t; const int* tp = (const int*)(ws + WS_TOKP) + 2 * t;
        const v4u* src = (const v4u*)((const bf16*)(ws + WS_H2) + (size_t)t * DM) + lane; const v4u a = src[0], c2 = src[64];
#pragma unroll
        for (int s = 0; s < 2; ++s) { const int rs = off[te[s]] + tp[s]; v4u* dst = (v4u*)(XS + (size_t)rs * DM) + lane; dst[0] = a; dst[64] = c2;
            if (lane == 0) { rinfo[rs] = 2 * t + s; roww[rs] = tw[s]; } }
    }
    for (int e = 0; e < NE; ++e) { const int n = off[40 + e], r0 = off[e] + n, r1 = off[e + 1];
        for (int rs = r0 + vb * NWAVES + wave; rs < r1; rs += nvb * NWAVES) { v4u* dst = (v4u*)(XS + (size_t)rs * DM) + lane; const v4u z = {0u, 0u, 0u, 0u}; dst[0] = z; dst[64] = z;
            if (lane == 0) { rinfo[rs] = -1; roww[rs] = 0.f; } } }
}
__device__ __forceinline__ void phase_final(const Params& P, int vb, int nvb) {
    const int tid = threadIdx.x, lane = tid & 63, wave = tid >> 6; unsigned char* ws = P.ws; const float* mod = (const float*)(ws + WS_MOD);
    for (int t = vb * NWAVES + wave; t < T; t += nvb * NWAVES) {
        const int b = t >> 12;
        f32x4* xr = (f32x4*)(P.out + (size_t)t * DM) + lane;
        const v2u* y0 = (const v2u*)((const bf16*)(ws + WS_Y) + (size_t)(2 * t) * DM) + lane; const v2u* y1 = y0 + DM / 4;
        f32x4 v[4]; float s = 0.f;
#pragma unroll
        for (int j = 0; j < 4; ++j) { const int d = 4 * lane + 256 * j; const f32x4 g2 = *(const f32x4*)(mod + b * 6144 + 5120 + d); const v2u a = y0[64 * j], c2 = y1[64 * j];
            v[j] = xr[64 * j];
            v[j].x += g2.x * (bflo(a.x) + bflo(c2.x)); v[j].y += g2.y * (bfhi(a.x) + bfhi(c2.x)); v[j].z += g2.z * (bflo(a.y) + bflo(c2.y)); v[j].w += g2.w * (bfhi(a.y) + bfhi(c2.y));
            s += (v[j].x * v[j].x + v[j].y * v[j].y) + (v[j].z * v[j].z + v[j].w * v[j].w); }
        const float rstd = rsqrtf(wave_sum(s) * (1.f / DM) + EPS);
#pragma unroll
        for (int j = 0; j < 4; ++j) { const f32x4 fw = *(const f32x4*)(P.final_norm_w + 4 * lane + 256 * j);
            xr[64 * j] = (f32x4){v[j].x * rstd * fw.x, v[j].y * rstd * fw.y, v[j].z * rstd * fw.z, v[j].w * rstd * fw.w}; }
    }
}

#define MFMA32(a, b, c) __builtin_amdgcn_mfma_f32_32x32x16_bf16((a), (b), (c), 0, 0, 0)
typedef __attribute__((address_space(3))) const char* lds_cptr;
typedef short v4i16_t __attribute__((ext_vector_type(4)));
typedef __bf16 bf16x2_t __attribute__((ext_vector_type(2)));
__device__ __forceinline__ s16x4 vtr(lds_cptr p) { return __builtin_bit_cast(s16x4, __builtin_amdgcn_ds_read_tr16_b64_v4i16((LAS v4i16_t*)p)); }
__device__ __forceinline__ int crow(int i, int hi) { return (i & 3) + 8 * (i >> 2) + 4 * hi; }
__device__ __forceinline__ unsigned cvtpk(float lo, float hi) { f32x2 v = {lo, hi}; bf16x2_t b = __builtin_convertvector(v, bf16x2_t); return __builtin_bit_cast(unsigned, b); }
#define PACK8(x, s) __builtin_bit_cast(bf16x8, (v4u){cvtpk((x)[8 * (s)], (x)[8 * (s) + 1]), cvtpk((x)[8 * (s) + 2], (x)[8 * (s) + 3]), cvtpk((x)[8 * (s) + 4], (x)[8 * (s) + 5]), cvtpk((x)[8 * (s) + 6], (x)[8 * (s) + 7])})
#define VFRAG(lo, hi4) (bf16x8){(lo)[0], (lo)[1], (lo)[2], (lo)[3], (hi4)[0], (hi4)[1], (hi4)[2], (hi4)[3]}
__device__ __forceinline__ void vtile_load(const bf16* g, int pitch, int wave, int lane, v4u (&reg)[2]) {
#pragma unroll
    for (int i = 0; i < 2; ++i) { const int pi = wave + 8 * i; reg[i] = *(const v4u*)(g + (size_t)(16 * (pi & 3) + (lane >> 2)) * pitch + (pi >> 2) * 32 + (lane & 3) * 8); }
}
__device__ __forceinline__ void vtile_store(LAS unsigned char* vbuf, int wave, int lane, const v4u (&reg)[2]) {
#pragma unroll
    for (int i = 0; i < 2; ++i) *(LAS v4u*)(vbuf + (wave + 8 * i) * 1024 + lane * 16) = reg[i];
}
__device__ __forceinline__ void ktile_load(const bf16* g, int pitch, int wave, int lane, v4u (&reg)[2]) {
#pragma unroll
    for (int i = 0; i < 2; ++i) reg[i] = *(const v4u*)(g + (size_t)lane * pitch + (wave + 8 * i) * 8);
}
__device__ __forceinline__ void ktile_store(LAS unsigned char* kbuf, int wave, int lane, const v4u (&reg)[2]) {
#pragma unroll
    for (int i = 0; i < 2; ++i) *(LAS v4u*)(kbuf + (wave + 8 * i) * 1024 + lane * 16) = reg[i];
}

#if FAST_ATTN
__device__ __forceinline__ void attn_unit(const Params& P, LAS unsigned char* lds, int b, int h, int qb, float lam) {
    const int tid = threadIdx.x, lane = tid & 63, r32 = lane & 31, hi = lane >> 5, wave = __builtin_amdgcn_readfirstlane(tid >> 6), m = wave >> 2, ws4 = wave & 3;
    unsigned char* ws = P.ws;
    const bf16* Kg = (const bf16*)(ws + WS_K) + (size_t)b * SEQ * HW + h * 128; const bf16* Vg = (const bf16*)(ws + WS_V) + (size_t)b * SEQ * HW + h * 128;
    const int q0 = qb * 128, NT = 2 * qb + 2, rowq = q0 + 32 * ws4 + r32, wrow0 = q0 + 32 * ws4;
    bf16x8 qf[4];
    { const bf16* Qg = (const bf16*)(ws + WS_Q) + ((size_t)b * SEQ + rowq) * HW + h * 128 + m * 64 + 8 * hi;
#pragma unroll
      for (int ks = 0; ks < 4; ++ks) qf[ks] = *(const bf16x8*)(Qg + 16 * ks); }
    v4u kr[2], vr[2];
    ktile_load(Kg, HW, wave, lane, kr); vtile_load(Vg, HW, wave, lane, vr);
    ktile_store(lds, wave, lane, kr); vtile_store(lds + 32768, wave, lane, vr);
    __syncthreads();
    f32x16 o[4];
#pragma unroll
    for (int d = 0; d < 4; ++d)
#pragma unroll
        for (int i = 0; i < 16; ++i) o[d][i] = 0.f;
    float mrun = -INFINITY, lrun = 0.f;
    const int voff = ((lane >> 4) & 1) * 32 + (lane & 3) * 8 + (4 * hi + ((lane & 15) >> 2)) * 64;
    for (int t = 0; t < NT; ++t) {
        LAS unsigned char* kbuf = lds + (t & 1) * 16384; LAS unsigned char* vbuf = lds + 32768 + (t & 1) * 16384;
        const bool more = t + 1 < NT;
        if (more) { ktile_load(Kg + (size_t)(t + 1) * 64 * HW, HW, wave, lane, kr); vtile_load(Vg + (size_t)(t + 1) * 64 * HW, HW, wave, lane, vr); }
        const int kbase = 64 * t;
        if (kbase <= wrow0 + 31) {
            f32x16 s0, s1;
#pragma unroll
            for (int i = 0; i < 16; ++i) { s0[i] = 0.f; s1[i] = 0.f; }
#pragma unroll
            for (int ks = 0; ks < 4; ++ks) { lds_cptr kp = (lds_cptr)kbuf + (m * 8 + 2 * ks + hi) * 1024 + r32 * 16;
                const bf16x8 k0 = *(const LAS bf16x8*)kp, k1 = *(const LAS bf16x8*)(kp + 512);
                s0 = MFMA32(k0, qf[ks], s0); s1 = MFMA32(k1, qf[ks], s1); }
            if (kbase + 63 > wrow0) {
#pragma unroll
                for (int i = 0; i < 16; ++i) { const int key = kbase + crow(i, hi); if (key > rowq) s0[i] = -INFINITY; if (key + 32 > rowq) s1[i] = -INFINITY; } }
            float mx = fmaxf(s0[0], s1[0]);
#pragma unroll
            for (int i = 1; i < 16; ++i) mx = fmaxf(mx, fmaxf(s0[i], s1[i]));
            mx = fmaxf(mx, __shfl_xor(mx, 32));
            const float mnew = fmaxf(mrun, mx), alpha = __builtin_amdgcn_exp2f(mrun - mnew); mrun = mnew;
            float rs = 0.f;
#pragma unroll
            for (int i = 0; i < 16; ++i) { s0[i] = __builtin_amdgcn_exp2f(s0[i] - mnew); s1[i] = __builtin_amdgcn_exp2f(s1[i] - mnew); rs += s0[i] + s1[i]; }
            lrun = lrun * alpha + rs;
#pragma unroll
            for (int d = 0; d < 4; ++d)
#pragma unroll
                for (int i = 0; i < 16; ++i) o[d][i] *= alpha;
            lds_cptr vp = (lds_cptr)vbuf + voff;
#pragma unroll
            for (int ks4 = 0; ks4 < 4; ++ks4) {
                const bf16x8 pf = (ks4 == 0) ? PACK8(s0, 0) : (ks4 == 1) ? PACK8(s0, 1) : (ks4 == 2) ? PACK8(s1, 0) : PACK8(s1, 1);
#pragma unroll
                for (int d = 0; d < 4; ++d) { const s16x4 lo = vtr(vp + d * 4096 + ks4 * 1024), h4 = vtr(vp + d * 4096 + ks4 * 1024 + 512);
                    o[d] = MFMA32(VFRAG(lo, h4), pf, o[d]); } }
        }
        if (more) { ktile_store(lds + ((t + 1) & 1) * 16384, wave, lane, kr); vtile_store(lds + 32768 + ((t + 1) & 1) * 16384, wave, lane, vr); }
        __syncthreads();
    }
    lrun += __shfl_xor(lrun, 32);
    const float inv = 1.f / lrun;
    LAS float* xch = (LAS float*)lds + ws4 * 4096;
    if (m == 1) {
#pragma unroll
        for (int d = 0; d < 4; ++d)
#pragma unroll
            for (int i = 0; i < 16; ++i) xch[(d * 16 + i) * 64 + lane] = o[d][i] * inv; }
    __syncthreads();
    if (m == 0) {
        float ss = 0.f;
#pragma unroll
        for (int d = 0; d < 4; ++d)
#pragma unroll
            for (int i = 0; i < 16; ++i) { const float v = o[d][i] * inv - lam * xch[(d * 16 + i) * 64 + lane]; o[d][i] = v; ss += v * v; }
        ss += __shfl_xor(ss, 32);
        const float rstd = rsqrtf(ss * (1.f / 128.f) + EPS) * 0.8f;
        bf16* dst = (bf16*)(ws + WS_MIXED) + ((size_t)b * SEQ + rowq) * DM + h * 128;
#pragma unroll
        for (int d = 0; d < 4; ++d)
#pragma unroll
            for (int g = 0; g < 4; ++g) { const int dv0 = 32 * d + 8 * g + 4 * hi; const f32x4 w = *(const f32x4*)(P.subln_w + dv0);
                v2u pk; pk.x = pk2(o[d][4 * g] * rstd * w.x, o[d][4 * g + 1] * rstd * w.y); pk.y = pk2(o[d][4 * g + 2] * rstd * w.z, o[d][4 * g + 3] * rstd * w.w);
                *(v2u*)(dst + dv0) = pk; }
    }
    __syncthreads();
}
__device__ __forceinline__ void attn_phase(const Params& P, LAS unsigned char* lds, int vb, int nvb) {
    const float lam = diff_lambda(P, threadIdx.x & 63);
    for (int u = vb; u < 256; u += nvb) { const int bh = u >> 4, p = u & 15, b = bh >> 2, h = bh & 3;
        attn_unit(P, lds, b, h, 31 - p, lam); attn_unit(P, lds, b, h, p, lam); }
}
#endif

#if FAST_HGRN
__device__ __forceinline__ void hgrn_pass_a(const Params& P, LAS unsigned char* lds, int vb, int nvb) {
    const int tid = threadIdx.x, lane = tid & 63, r32 = lane & 31, hi = lane >> 5, wave = __builtin_amdgcn_readfirstlane(tid >> 6), k = tid & 127, seg = tid >> 7;
    unsigned char* ws = P.ws;
    LAS float* tot = (LAS float*)lds; LAS unsigned char* ktT = lds + 2048; LAS unsigned char* vimg = lds + 20480;
    const float* LF = (const float*)(ws + WS_LF); const bf16* GI = (const bf16*)(ws + WS_GI);
    bf16* U = (bf16*)((unsigned char*)P.out + DO_U); float* Dd = (float*)((unsigned char*)P.out + DO_D);
    for (int u = vb; u < 1024; u += nvb) {
        const int bh = u >> 6, c = u & 63, b = bh >> 2, h = bh & 3; const size_t row0 = (size_t)b * SEQ + c * 64;
        { v4u vr[2]; vtile_load(GI + row0 * HW + h * 128, HW, wave, lane, vr); vtile_store(vimg, wave, lane, vr); }
        float lf[16], bc[16], run = 0.f;
#pragma unroll
        for (int i = 0; i < 16; ++i) lf[i] = LF[(row0 + seg * 16 + i) * HW + h * 128 + k];
#pragma unroll
        for (int i = 0; i < 16; ++i) { run += lf[i]; bc[i] = run; }
        tot[seg * 128 + k] = run;
        __syncthreads();
        float pre = 0.f, all = 0.f;
#pragma unroll
        for (int s = 0; s < 4; ++s) { const float tv = tot[s * 128 + k]; all += tv; if (s < seg) pre += tv; }
        unsigned w[8];
#pragma unroll
        for (int i = 0; i < 8; ++i) { const float a = (1.f - __expf(lf[2 * i])) * __expf(all - pre - bc[2 * i]), c2 = (1.f - __expf(lf[2 * i + 1])) * __expf(all - pre - bc[2 * i + 1]); w[i] = pk2(a, c2); }
        *(LAS v4u*)(ktT + k * 144 + seg * 32) = (v4u){w[0], w[1], w[2], w[3]}; *(LAS v4u*)(ktT + k * 144 + seg * 32 + 16) = (v4u){w[4], w[5], w[6], w[7]};
        if (seg == 0) Dd[(size_t)u * 128 + k] = __expf(all);
        __syncthreads();
        const int vbk = wave >> 1, kb2 = (wave & 1) * 2;
        f32x16 a0, a1;
#pragma unroll
        for (int i = 0; i < 16; ++i) { a0[i] = 0.f; a1[i] = 0.f; }
        lds_cptr vp = (lds_cptr)vimg + vbk * 4096 + ((lane >> 4) & 1) * 32 + (lane & 3) * 8 + (8 * hi + ((lane & 15) >> 2)) * 64;
#pragma unroll
        for (int s = 0; s < 4; ++s) { const s16x4 lo = vtr(vp + s * 1024), h4 = vtr(vp + s * 1024 + 256); const bf16x8 vf = VFRAG(lo, h4);
            const bf16x8 k0 = *(const LAS bf16x8*)(ktT + (32 * kb2 + r32) * 144 + (16 * s + 8 * hi) * 2), k1 = *(const LAS bf16x8*)(ktT + (32 * kb2 + 32 + r32) * 144 + (16 * s + 8 * hi) * 2);
            a0 = MFMA32(vf, k0, a0); a1 = MFMA32(vf, k1, a1); }
        bf16* Ub = U + (size_t)u * 16384;
#pragma unroll
        for (int i = 0; i < 16; ++i) { const int v = 32 * vbk + crow(i, hi); Ub[v * 128 + 32 * kb2 + r32] = (bf16)f2bf(a0[i]); Ub[v * 128 + 32 * kb2 + 32 + r32] = (bf16)f2bf(a1[i]); }
        __syncthreads();
    }
}
__device__ __forceinline__ void hgrn_pass_b(const Params& P, int vb, int nvb) {
    unsigned* U = (unsigned*)((unsigned char*)P.out + DO_U); const float* Dd = (const float*)((unsigned char*)P.out + DO_D);
    for (int idx = vb * NTHR + threadIdx.x; idx < 16 * 128 * 64; idx += nvb * NTHR) {
        const int bh = idx >> 13, rem = idx & 8191, v = rem >> 6, kp = rem & 63;
        unsigned* up = U + (size_t)bh * 64 * 8192 + v * 64 + kp; const float* dp = Dd + (size_t)bh * 64 * 128 + 2 * kp;
        float s0 = 0.f, s1 = 0.f;
#pragma unroll 8
        for (int c = 0; c < 64; ++c) { const unsigned w = up[(size_t)c * 8192]; const f32x2 d = *(const f32x2*)(dp + c * 128);
            up[(size_t)c * 8192] = pk2(s0, s1); s0 = d.x * s0 + bflo(w); s1 = d.y * s1 + bfhi(w); }
    }
}
__device__ __forceinline__ void hgrn_pass_c(const Params& P, LAS unsigned char* lds, int vb, int nvb) {
    const int tid = threadIdx.x, lane = tid & 63, r32 = lane & 31, hi = lane >> 5, wave = __builtin_amdgcn_readfirstlane(tid >> 6), k = tid & 127, seg = tid >> 7;
    unsigned char* ws = P.ws;
    LAS float* tot = (LAS float*)lds; LAS float* part = (LAS float*)(lds + 2048); LAS unsigned char* qt = lds + 4096; LAS unsigned char* kh = lds + 21504; LAS unsigned char* vimg = lds + 38912;
    const float* LF = (const float*)(ws + WS_LF); const bf16* GI = (const bf16*)(ws + WS_GI); const bf16* GQ = (const bf16*)(ws + WS_GQ); const bf16* GG = (const bf16*)(ws + WS_GG);
    const bf16* U = (const bf16*)((unsigned char*)P.out + DO_U); bf16* MX = (bf16*)(ws + WS_MIXED);
    for (int u = vb; u < 1024; u += nvb) {
        const int bh = u >> 6, c = u & 63, b = bh >> 2, h = bh & 3; const size_t row0 = (size_t)b * SEQ + c * 64;
        { v4u vr[2]; vtile_load(GI + row0 * HW + h * 128, HW, wave, lane, vr); vtile_store(vimg, wave, lane, vr); }
        float lf[16], bc[16], run = 0.f; unsigned short qv[16];
#pragma unroll
        for (int i = 0; i < 16; ++i) { lf[i] = LF[(row0 + seg * 16 + i) * HW + h * 128 + k]; qv[i] = GQ[(row0 + seg * 16 + i) * HW + h * 128 + k]; }
#pragma unroll
        for (int i = 0; i < 16; ++i) { run += lf[i]; bc[i] = run; }
        tot[seg * 128 + k] = run;
        __syncthreads();
        float pre = 0.f;
#pragma unroll
        for (int s = 0; s < 3; ++s) { const float tv = tot[s * 128 + k]; if (s < seg) pre += tv; }
#pragma unroll
        for (int i = 0; i < 16; ++i) { const int t = seg * 16 + i; const float bb = pre + bc[i];
            *(LAS unsigned short*)(qt + t * 272 + k * 2) = (unsigned short)f2bf(bf2f(qv[i]) * __expf(bb));
            *(LAS unsigned short*)(kh + t * 272 + k * 2) = (unsigned short)f2bf((1.f - __expf(lf[i])) * __expf(-bb)); }
        __syncthreads();
        const int vbk = wave >> 1, tb = wave & 1;
        f32x16 acc;
#pragma unroll
        for (int i = 0; i < 16; ++i) acc[i] = 0.f;
        bf16x8 bq[8];
        { const bf16* Sg = U + (size_t)u * 16384 + (32 * vbk + r32) * 128 + 8 * hi;
#pragma unroll
          for (int ks = 0; ks < 8; ++ks) { const bf16x8 a = *(const bf16x8*)(Sg + 16 * ks); bq[ks] = *(const LAS bf16x8*)(qt + (32 * tb + r32) * 272 + (16 * ks + 8 * hi) * 2); acc = MFMA32(a, bq[ks], acc); } }
        for (int sb = 0; sb <= tb; ++sb) {
            f32x16 sc;
#pragma unroll
            for (int i = 0; i < 16; ++i) sc[i] = 0.f;
#pragma unroll
            for (int ks = 0; ks < 8; ++ks) { const bf16x8 kf = *(const LAS bf16x8*)(kh + (32 * sb + r32) * 272 + (16 * ks + 8 * hi) * 2); sc = MFMA32(kf, bq[ks], sc); }
            if (sb == tb) {
#pragma unroll
                for (int i = 0; i < 16; ++i) if (crow(i, hi) > r32) sc[i] = 0.f; }
            lds_cptr vp = (lds_cptr)vimg + vbk * 4096 + ((lane >> 4) & 1) * 32 + (lane & 3) * 8 + (32 * sb + 4 * hi + ((lane & 15) >> 2)) * 64;
            { const bf16x8 pf = PACK8(sc, 0); const s16x4 lo = vtr(vp), h4 = vtr(vp + 512); acc = MFMA32(VFRAG(lo, h4), pf, acc); }
            { const bf16x8 pf = PACK8(sc, 1); const s16x4 lo = vtr(vp + 1024), h4 = vtr(vp + 1024 + 512); acc = MFMA32(VFRAG(lo, h4), pf, acc); }
        }
        float ss = 0.f;
#pragma unroll
        for (int i = 0; i < 16; ++i) ss += acc[i] * acc[i];
        ss += __shfl_xor(ss, 32);
        if (hi == 0) part[vbk * 64 + 32 * tb + r32] = ss;
        __syncthreads();
        const float tss = (part[32 * tb + r32] + part[64 + 32 * tb + r32]) + (part[128 + 32 * tb + r32] + part[192 + 32 * tb + r32]);
        const float rstd = rsqrtf(tss * (1.f / 128.f) + EPS);
        const size_t row = row0 + 32 * tb + r32;
#pragma unroll
        for (int g = 0; g < 4; ++g) { const int v0 = 32 * vbk + 8 * g + 4 * hi; const v2u gg = *(const v2u*)(GG + row * HW + h * 128 + v0); const f32x4 nw = *(const f32x4*)(P.hg_norm_w + v0);
            v2u pk; pk.x = pk2(acc[4 * g] * rstd * nw.x * bflo(gg.x), acc[4 * g + 1] * rstd * nw.y * bfhi(gg.x)); pk.y = pk2(acc[4 * g + 2] * rstd * nw.z * bflo(gg.y), acc[4 * g + 3] * rstd * nw.w * bfhi(gg.y));
            *(v2u*)(MX + row * DM + 512 + h * 128 + v0) = pk; }
        __syncthreads();
    }
}
#endif

__device__ __forceinline__ void phase_mix_a(const Params& P, LAS unsigned char* lds, int vb, int nvb) {
#if FAST_HGRN
    hgrn_pass_a(P, lds, vb, nvb);
#else
    naive_hgrn_rec(P, vb, nvb);
#endif
#if FAST_ATTN
    attn_phase(P, lds, vb, nvb);
#else
    naive_attn(P, lds, vb, nvb);
#endif
}
__device__ __forceinline__ void phase_mix_b(const Params& P, LAS unsigned char* lds, int vb, int nvb) {
#if FAST_HGRN
    hgrn_pass_b(P, vb, nvb);
#else
    naive_hgrn_norm(P, vb, nvb);
#endif
}
__device__ __forceinline__ void phase_mix_c(const Params& P, LAS unsigned char* lds, int vb, int nvb) {
#if FAST_HGRN
    hgrn_pass_c(P, lds, vb, nvb);
#endif
}

#define XB_TMO      128
#define XB_XCNT(j)  (256  + 64 * (j))
#define XB_XSUB(j)  (1280 + 64 * (j))
#define XB_XGEN(j)  (2304 + 64 * (j))
#define XB_TOP      3328
#define XB_TOPGEN   3392
#define XCD_BAR_WORDS 3456
#define XB_SPIN_CAP (1u << 18)

__device__ __forceinline__ unsigned xb_ld(unsigned* p)              { return __hip_atomic_load(p, __ATOMIC_RELAXED, __HIP_MEMORY_SCOPE_AGENT); }
__device__ __forceinline__ unsigned xb_add(unsigned* p, unsigned v) { return __hip_atomic_fetch_add(p, v, __ATOMIC_RELAXED, __HIP_MEMORY_SCOPE_AGENT); }
__device__ __forceinline__ unsigned xb_xcc_id() { return (unsigned)__builtin_amdgcn_s_getreg((3 << 11) | 20) & 0xFu; }
#define XB_SPIN(cond, bar) do { unsigned _sp = 0; while (cond) { __builtin_amdgcn_s_sleep(1); \
    if ((++_sp & 255u) == 0u) { if (xb_ld(&(bar)[XB_TMO])) break; if (_sp > XB_SPIN_CAP) { atomicAdd(&(bar)[XB_TMO], 1u); break; } } } } while (0)

struct XcdBarrier {
    unsigned* bar; unsigned x;
    volatile LAS unsigned* st;
};

__device__ __forceinline__ XcdBarrier xcd_barrier_post(unsigned* bar, volatile LAS unsigned* st) {
    XcdBarrier b; b.bar = bar; b.x = xb_xcc_id(); b.st = st;
    if (threadIdx.x == 0) (void)xb_add(&bar[XB_XCNT(b.x)], 1u);
    return b;
}
__device__ __forceinline__ void xcd_barrier_complete(unsigned* bar, unsigned x, unsigned& nloc, unsigned& nx) {
    const unsigned G = gridDim.x * gridDim.y * gridDim.z;
    unsigned sum, cnt, mine, sp = 0u;
    for (;;) {
        sum = 0u; cnt = 0u; mine = 0u;
#pragma unroll
        for (unsigned j = 0; j < 16; ++j) { const unsigned c = xb_ld(&bar[XB_XCNT(j)]); sum += c; cnt += (c > 0u) ? 1u : 0u; mine = (j == x) ? c : mine; }
        if (sum == G) break;
        __builtin_amdgcn_s_sleep(1);
        if ((++sp & 255u) == 0u) { if (xb_ld(&bar[XB_TMO])) break; if (sp > XB_SPIN_CAP) { atomicAdd(&bar[XB_TMO], 1u); break; } }
    }
    nloc = mine > 0u ? mine : 1u; nx = cnt > 0u ? cnt : 1u;
}

__device__ __forceinline__ void xcd_barrier(const XcdBarrier& b) {
    asm volatile("s_waitcnt vmcnt(0)" ::: "memory");
    __syncthreads();
    if (threadIdx.x == 0) {
        unsigned* bar = b.bar;
        __builtin_amdgcn_s_waitcnt(0);
        unsigned nloc = b.st[0], nx = b.st[1];
        if (nloc == 0u) { xcd_barrier_complete(bar, b.x, nloc, nx); b.st[0] = nloc; b.st[1] = nx; }
        const unsigned old = xb_add(&bar[XB_XSUB(b.x)], 1u);
        const unsigned gen = old / nloc;
        if (old + 1u == (gen + 1u) * nloc) {
            __builtin_amdgcn_fence(__ATOMIC_RELEASE, "agent");
            asm volatile("s_waitcnt vmcnt(0)" ::: "memory");
            const unsigned og = xb_add(&bar[XB_TOP], 1u);
            const unsigned tg = og / nx;
            if (og + 1u == (tg + 1u) * nx) xb_add(&bar[XB_TOPGEN], 1u);
            else XB_SPIN(xb_ld(&bar[XB_TOPGEN]) == tg, bar);
            __builtin_amdgcn_fence(__ATOMIC_ACQUIRE, "agent");
            xb_add(&bar[XB_XGEN(b.x)], 1u);
            asm volatile("s_waitcnt vmcnt(0)" ::: "memory");
        } else {
            XB_SPIN(xb_ld(&bar[XB_XGEN(b.x)]) == gen, bar);
            __builtin_amdgcn_fence(__ATOMIC_ACQUIRE, "agent");
            asm volatile("s_waitcnt vmcnt(0)" ::: "memory");
        }
    }
    __syncthreads();
}

enum { PH_PREP = 0, PH_FOLD, PH_GEMM1, PH_MIX_A, PH_MIX_B, PH_MIX_C, PH_OUTPROJ, PH_ROUTE, PH_SCATTER, PH_GATEUP, PH_DOWN, PH_FINAL, PH_COUNT };

template <int PH> __device__ __forceinline__ void run_phase(const Params& P, LAS unsigned char* lds, int vb, int bx, int G) {
    if constexpr (PH == PH_PREP) phase_prep(P, lds, vb, G);
    else if constexpr (PH == PH_FOLD) phase_fold(P, lds, vb, G);
    else if constexpr (PH == PH_GEMM1) phase_gemm1(P, lds, bx, G);
    else if constexpr (PH == PH_MIX_A) phase_mix_a(P, lds, vb, G);
    else if constexpr (PH == PH_MIX_B) phase_mix_b(P, lds, vb, G);
    else if constexpr (PH == PH_MIX_C) phase_mix_c(P, lds, vb, G);
    else if constexpr (PH == PH_OUTPROJ) phase_outproj(P, lds, bx, G);
    else if constexpr (PH == PH_ROUTE) phase_route(P, vb, G);
    else if constexpr (PH == PH_SCATTER) phase_scatter(P, lds, vb, G);
    else if constexpr (PH == PH_GATEUP) phase_gateup(P, lds, bx, G);
    else if constexpr (PH == PH_DOWN) phase_down(P, lds, bx, G);
    else if constexpr (PH == PH_FINAL) phase_final(P, vb, G);
}
#define VB_OF(G, bx) (((G) % 8 == 0) ? ((bx) % 8) * ((G) / 8) + (bx) / 8 : (bx))
#if ONE_LAUNCH
#ifndef N_CG_SYNC
#define N_CG_SYNC 1
#endif
__global__ void __launch_bounds__(NTHR, 2) hymba_fwd(Params P) {
    extern __shared__ __attribute__((aligned(16))) unsigned char lds_raw[];
    LAS unsigned char* lds = (LAS unsigned char*)lds_raw;
    const int G = gridDim.x, bx = blockIdx.x, vb = VB_OF(G, bx);
    cg::grid_group grid = cg::this_grid();
    LAS unsigned* lctl = (LAS unsigned*)(lds + LDS_CTL_OFF);
    if (threadIdx.x < 64) lctl[threadIdx.x] = 0u;
    __syncthreads();
    (void)xcd_barrier_post((unsigned*)(P.ws + WS_CTL) + CW_BAR, (volatile LAS unsigned*)lctl);
#define RUN(PH) do { if constexpr ((PHASE_MASK >> PH) & 1) run_phase<PH>(P, lds, vb, bx, G); \
        if (PH + 1 < PH_COUNT) { if (PH < N_CG_SYNC) grid.sync(); else { XcdBarrier b_; b_.bar = (unsigned*)(P.ws + WS_CTL) + CW_BAR; b_.x = xb_xcc_id(); b_.st = (volatile LAS unsigned*)(lds + LDS_CTL_OFF); xcd_barrier(b_); } } } while (0)
    RUN(0); RUN(1); RUN(2); RUN(3); RUN(4); RUN(5); RUN(6); RUN(7); RUN(8); RUN(9); RUN(10); RUN(11);
#undef RUN
}
#else
template <int PH> __global__ void __launch_bounds__(NTHR, 2) k_phase(Params P) {
    extern __shared__ __attribute__((aligned(16))) unsigned char lds_raw[];
    LAS unsigned char* lds = (LAS unsigned char*)lds_raw;
    const int G = gridDim.x, bx = blockIdx.x, vb = VB_OF(G, bx);
    run_phase<PH>(P, lds, vb, bx, G);
}
template <int PH> static bool launch_phase(const Params& p, int grid, hipStream_t stream) {
    static bool attr = false;
    if (!attr) { if (hipFuncSetAttribute((const void*)k_phase<PH>, hipFuncAttributeMaxDynamicSharedMemorySize, LDS_BYTES) != hipSuccess) { fprintf(stderr, "hipFuncSetAttribute failed (phase %d)\n", PH); return false; } attr = true; }
    hipLaunchKernelGGL(k_phase<PH>, dim3(grid), dim3(NTHR), LDS_BYTES, stream, p);
    return true;
}
#endif

extern "C" void kernel_launch(void* const* d_in, const int* in_sizes, int n_in, void* d_out, int out_size, void* d_ws, size_t ws_size, hipStream_t stream) {
    static int grid = 0;
    if (grid == 0) {
        if (n_in != 24 || out_size != T * DM || ws_size < WS_END) { fprintf(stderr, "kernel_launch: unexpected shapes (n_in %d out %d ws %zu)\n", n_in, out_size, ws_size); grid = -1; return; }
        int dev = 0, cus = 0;
        if (hipGetDevice(&dev) != hipSuccess || hipDeviceGetAttribute(&cus, hipDeviceAttributeMultiprocessorCount, dev) != hipSuccess) { grid = -1; return; }
#if ONE_LAUNCH
        int per_cu = 0;
        if (hipFuncSetAttribute((const void*)hymba_fwd, hipFuncAttributeMaxDynamicSharedMemorySize, LDS_BYTES) != hipSuccess) { fprintf(stderr, "kernel_launch: hipFuncSetAttribute failed\n"); grid = -1; return; }
        if (hipOccupancyMaxActiveBlocksPerMultiprocessor(&per_cu, (const void*)hymba_fwd, NTHR, LDS_BYTES) != hipSuccess || per_cu < 1) { fprintf(stderr, "kernel_launch: occupancy query says %d blocks per CU\n", per_cu); grid = -1; return; }
#endif
        grid = cus;
        (void)hipGetLastError();
    }
    if (grid < 0) return;
    (void)hipMemsetAsync((char*)d_ws + WS_CTL, 0, CTL_ZERO_BYTES, stream);
    Params p{};
    p.x = (const float*)d_in[0]; p.c = (const float*)d_in[1]; p.positions = (const int*)d_in[2]; p.norm1_w = (const float*)d_in[3]; p.norm2_w = (const float*)d_in[4];
    p.final_norm_w = (const float*)d_in[5]; p.ada_w = (const float*)d_in[6]; p.ada_b = (const float*)d_in[7]; p.w_in = (const float*)d_in[8]; p.w_out = (const float*)d_in[9];
    p.lq1 = (const float*)d_in[10]; p.lk1 = (const float*)d_in[11]; p.lq2 = (const float*)d_in[12]; p.lk2 = (const float*)d_in[13]; p.subln_w = (const float*)d_in[14];
    p.hg_lb = (const float*)d_in[15]; p.hg_norm_w = (const float*)d_in[16]; p.w_group = (const float*)d_in[17]; p.b_group = (const float*)d_in[18];
    p.w_router = (const float*)d_in[19]; p.b_router = (const float*)d_in[20]; p.w_gate = (const float*)d_in[21]; p.w_up = (const float*)d_in[22]; p.w_down = (const float*)d_in[23];
    p.out = (float*)d_out; p.ws = (unsigned char*)d_ws; p.ph_lo = 0; p.ph_hi = PH_COUNT;
#if ONE_LAUNCH
    void* args[] = {&p};
    hipError_t e = hipLaunchCooperativeKernel((const void*)hymba_fwd, dim3(grid), dim3(NTHR), args, LDS_BYTES, stream);
    if (e != hipSuccess) fprintf(stderr, "cooperative launch failed: %s (grid %d)\n", hipGetErrorString(e), grid);
#else
    launch_phase<0>(p, grid, stream); launch_phase<1>(p, grid, stream); launch_phase<2>(p, grid, stream); launch_phase<3>(p, grid, stream);
    launch_phase<4>(p, grid, stream); launch_phase<5>(p, grid, stream); launch_phase<6>(p, grid, stream); launch_phase<7>(p, grid, stream);
    launch_phase<8>(p, grid, stream); launch_phase<9>(p, grid, stream); launch_phase<10>(p, grid, stream); launch_phase<11>(p, grid, stream);
#endif
}
```

```cpp
#include <hip/hip_runtime.h>
#include <hip/hip_cooperative_groups.h>
#include <cstdio>
#include <cstdint>
#include <cmath>
namespace cg = cooperative_groups;

namespace pg8 {
#define PG8_LAS __attribute__((address_space(3)))
typedef unsigned short bf16_t;
typedef short bf16x8 __attribute__((ext_vector_type(8)));
typedef float f32x4 __attribute__((ext_vector_type(4)));
typedef unsigned u32x4 __attribute__((ext_vector_type(4)));
constexpr int BM = 256, BK = 64, HALF = 128, HTB = HALF * BK * 2  , STAGE_BYTES = 8 * HTB, NXCD = 8, WGM = 8;

__host__ __device__ __forceinline__ int lds_byte(int r, int c) { const int st = (r >> 4) * 2 + (c >> 5), rr = r & 15, cc = c & 31, ob = rr * 64 + cc * 2; return st * 1024 + (ob ^ (((ob >> 9) & 1) << 5)); }
__host__ __device__ __forceinline__ void stage_rc(int b, int& R, int& C) { const int st = b / 1024, sb = b % 1024, swz = sb ^ (((sb >> 9) & 1) << 5); R = (st >> 1) * 16 + swz / 64; C = (st & 1) * 32 + (swz % 64) / 2; }
__host__ __device__ __forceinline__ int perm32(int rho) { const int n = rho >> 4, i = rho & 15; return 8 * (i >> 2) + 4 * n + (i & 3); }

struct Unit { int pm, pn; };
struct Gemm { const bf16_t* A; const bf16_t* Bt; int M, N, K; };

struct StaticOrder {
    int nM, nN, nwg, G, c;
    __host__ __device__ void init(int M, int N, int G_, int c_) { nM = M / BM; nN = N / BM; nwg = nM * nN; G = G_; c = c_; }
    __host__ __device__ bool next(int i, Unit& u) const {
        const long L = (long)i * G + c; if (L >= nwg) return false;
        int wgid = (int)L; { const int q = nwg / NXCD, r = nwg % NXCD, xcd = wgid % NXCD, off = wgid / NXCD; wgid = (xcd < r ? xcd * (q + 1) : r * (q + 1) + (xcd - r) * q) + off; }
        const int nig = WGM * nN, gid = wgid / nig, fm = gid * WGM, gsz = (nM - fm) < WGM ? (nM - fm) : WGM;
        u.pm = fm + ((wgid % nig) % gsz); u.pn = (wgid % nig) / gsz; return true;
    }
    __device__ __forceinline__ void a_ready(const Unit&) const {}
    __device__ __forceinline__ void done(const Unit&) const {}
};


__device__ __forceinline__ unsigned cvt_pk_bf16(float lo, float hi) { unsigned r; asm volatile("v_cvt_pk_bf16_f32 %0, %1, %2" : "=v"(r) : "v"(lo), "v"(hi)); return r; }
typedef float f32x2 __attribute__((ext_vector_type(2)));

template <class Epi, class Sched, bool ALIGN_EPI = false, bool SP2 = false>
__device__ __forceinline__ void gemm_phase(PG8_LAS unsigned char* lds, const Gemm g, const Sched& S, const Epi& E) {
    int tid_ = threadIdx.x; asm volatile("" : "+v"(tid_));
    const int tid = tid_, wid = __builtin_amdgcn_readfirstlane(tid >> 6), lane = tid & 63, wr = wid >> 2, wc = wid & 3, fr = lane & 15, fq = lane >> 4;
    const int K = g.K, nt = K / BK;
    unsigned voffA[2], voffB[2];
#pragma unroll
    for (int i = 0; i < 2; ++i) { int R, C; stage_rc(tid * 16 + i * 8192, R, C); const int Rb = Epi::PERM ? ((R & ~31) + perm32(R & 31)) : R;
        voffA[i] = (unsigned)(R * K + C) * 2u; voffB[i] = (unsigned)(Rb * K + C) * 2u; }
    const size_t kstep = (size_t)(BK * 2);
    const size_t hstep = (size_t)HALF * K * 2;
    const size_t tstep = 2 * hstep;
    const unsigned ldsw = (unsigned)wid * 1024u;
    const int aoff = lds_byte(wr * 64 + fr, fq * 8), boff = lds_byte(wc * 32 + fr, fq * 8);
#define PG8_SA(b, h) (((b) * 2 + (h)) * HTB)
#define PG8_SB(b, h) ((4 + (b) * 2 + (h)) * HTB)
#define PG8_STAGE(bufoff, gbase, voff) do { _Pragma("unroll") for (int _i = 0; _i < 2; ++_i) \
        __builtin_amdgcn_global_load_lds((const unsigned*)((const char*)(gbase) + (voff)[_i]), (PG8_LAS unsigned*)(lds + (bufoff) + ldsw + _i * 8192), 16, 0, 0); } while (0)
#define PG8_LDA(dst, b, h) do { _Pragma("unroll") for (int m = 0; m < 4; ++m) _Pragma("unroll") for (int k = 0; k < 2; ++k) dst[m][k] = *(const PG8_LAS bf16x8*)(lds + PG8_SA(b, h) + aoff + m * 2048 + k * 1024); } while (0)
#define PG8_LDB(dst, b, h) do { _Pragma("unroll") for (int n = 0; n < 2; ++n) _Pragma("unroll") for (int k = 0; k < 2; ++k) dst[n][k] = *(const PG8_LAS bf16x8*)(lds + PG8_SB(b, h) + boff + n * 2048 + k * 1024); } while (0)
#define PG8_MMA(ai, bj, At, Bt) do { __builtin_amdgcn_s_setprio(1); _Pragma("unroll") for (int m = 0; m < 4; ++m) _Pragma("unroll") for (int n = 0; n < 2; ++n) _Pragma("unroll") for (int k = 0; k < 2; ++k) \
        acc[ai][bj][m][n] = __builtin_amdgcn_mfma_f32_16x16x32_bf16(Bt[n][k], At[m][k], acc[ai][bj][m][n], 0, 0, 0); __builtin_amdgcn_s_setprio(0); } while (0)
#define PG8_WAIT_V(n) asm volatile("s_waitcnt vmcnt(" #n ")" ::: "memory")
#define PG8_WAIT_L(n) asm volatile("s_waitcnt lgkmcnt(" #n ")" ::: "memory")
#define PG8_BAR __builtin_amdgcn_s_barrier()
#define PG8_SCHED __builtin_amdgcn_sched_barrier(0)
    Unit cur, nxt; int ui = 0;
    if (!S.next(0, cur)) return;
    f32x4 acc[2][2][4][2];
#pragma unroll
    for (int a = 0; a < 2; ++a)
#pragma unroll
        for (int b = 0; b < 2; ++b)
#pragma unroll
            for (int m = 0; m < 4; ++m)
#pragma unroll
                for (int n = 0; n < 2; ++n) acc[a][b][m][n] = (f32x4){0.f, 0.f, 0.f, 0.f};
    bf16x8 At[4][2], B0[2][2], B1[2][2];
    const char* cA = (const char*)g.A + (size_t)cur.pm * tstep; const char* cB = (const char*)g.Bt + (size_t)cur.pn * tstep;
    S.a_ready(cur);
    if constexpr (SP2) {
        PG8_STAGE(PG8_SB(0, 0), cB, voffB); PG8_STAGE(PG8_SB(0, 1), cB + hstep, voffB); PG8_STAGE(PG8_SA(0, 0), cA, voffA); PG8_STAGE(PG8_SA(0, 1), cA + hstep, voffA);
        if (wr == 1) PG8_BAR;
        PG8_WAIT_V(2); PG8_BAR;
        PG8_STAGE(PG8_SB(1, 0), cB + kstep, voffB); PG8_STAGE(PG8_SA(1, 0), cA + kstep, voffA); PG8_STAGE(PG8_SB(1, 1), cB + hstep + kstep, voffB);
        PG8_WAIT_V(6); PG8_BAR;
    } else {
        PG8_STAGE(PG8_SB(0, 0), cB, voffB); PG8_STAGE(PG8_SA(0, 0), cA, voffA); PG8_STAGE(PG8_SB(0, 1), cB + hstep, voffB); PG8_STAGE(PG8_SA(0, 1), cA + hstep, voffA);
        if (wr == 1) PG8_BAR;
        PG8_WAIT_V(4); PG8_BAR;
        PG8_STAGE(PG8_SB(1, 0), cB + kstep, voffB); PG8_STAGE(PG8_SA(1, 0), cA + kstep, voffA); PG8_STAGE(PG8_SB(1, 1), cB + hstep + kstep, voffB);
        PG8_WAIT_V(6); PG8_BAR;
    }
    for (;;) {
        const bool has_next = S.next(ui + 1, nxt);
        const char* nA = has_next ? (const char*)g.A + (size_t)nxt.pm * tstep : cA; const char* nB = has_next ? (const char*)g.Bt + (size_t)nxt.pn * tstep : cB;
        for (int t = 0; t < nt; t += 2) {
            const bool last = (t == nt - 2);
            const char* a1 = cA + (size_t)(t + 1) * kstep;
            const char* a2 = last ? nA : cA + (size_t)(t + 2) * kstep; const char* b2 = last ? nB : cB + (size_t)(t + 2) * kstep;
            const char* a3 = a2 + kstep; const char* b3 = b2 + kstep;
            if (last && has_next) S.a_ready(nxt);
            if constexpr (SP2) {
            PG8_LDB(B0, 0, 0); PG8_LDB(B1, 0, 1); PG8_SCHED; PG8_LDA(At, 0, 0); PG8_STAGE(PG8_SA(1, 1), a1 + hstep, voffA);
            PG8_WAIT_V(8); PG8_WAIT_L(0); PG8_BAR; PG8_MMA(0, 0, At, B0); PG8_MMA(0, 1, At, B1); PG8_BAR; PG8_SCHED;
            PG8_LDA(At, 0, 1); PG8_STAGE(PG8_SB(0, 0), b2, voffB); PG8_STAGE(PG8_SB(0, 1), b2 + hstep, voffB); PG8_STAGE(PG8_SA(0, 0), a2, voffA);
            PG8_WAIT_V(8); PG8_WAIT_L(0); PG8_BAR; PG8_MMA(1, 0, At, B0); PG8_MMA(1, 1, At, B1); PG8_BAR; PG8_SCHED;
            PG8_LDB(B0, 1, 0); PG8_LDB(B1, 1, 1); PG8_SCHED; PG8_LDA(At, 1, 0); PG8_STAGE(PG8_SA(0, 1), a2 + hstep, voffA);
            PG8_WAIT_V(8); PG8_WAIT_L(0); PG8_BAR; PG8_MMA(0, 0, At, B0); PG8_MMA(0, 1, At, B1); PG8_BAR; PG8_SCHED;
            PG8_LDA(At, 1, 1); PG8_STAGE(PG8_SB(1, 0), b3, voffB); PG8_STAGE(PG8_SB(1, 1), b3 + hstep, voffB); PG8_STAGE(PG8_SA(1, 0), a3, voffA);
            PG8_WAIT_V(8); PG8_WAIT_L(0); PG8_BAR; PG8_MMA(1, 0, At, B0); PG8_MMA(1, 1, At, B1); PG8_BAR; PG8_SCHED;
            } else {
            PG8_LDB(B0, 0, 0); PG8_SCHED; PG8_LDA(At, 0, 0); PG8_STAGE(PG8_SA(1, 1), a1 + hstep, voffA);
            PG8_WAIT_L(8); PG8_BAR; PG8_WAIT_L(0); PG8_MMA(0, 0, At, B0); PG8_BAR; PG8_SCHED;
            PG8_LDB(B1, 0, 1); PG8_STAGE(PG8_SB(0, 0), b2, voffB);
            PG8_BAR; PG8_WAIT_L(0); PG8_MMA(0, 1, At, B1); PG8_BAR;
            PG8_LDA(At, 0, 1); PG8_STAGE(PG8_SA(0, 0), a2, voffA);
            PG8_BAR; PG8_WAIT_L(0); PG8_MMA(1, 0, At, B0); PG8_BAR; PG8_SCHED;
            PG8_STAGE(PG8_SB(0, 1), b2 + hstep, voffB);
            PG8_WAIT_V(6); PG8_BAR; PG8_MMA(1, 1, At, B1); PG8_BAR;
            PG8_LDB(B0, 1, 0); PG8_SCHED; PG8_LDA(At, 1, 0); PG8_STAGE(PG8_SA(0, 1), a2 + hstep, voffA);
            PG8_WAIT_L(8); PG8_BAR; PG8_WAIT_L(0); PG8_MMA(0, 0, At, B0); PG8_BAR; PG8_SCHED;
            PG8_LDB(B1, 1, 1); PG8_STAGE(PG8_SB(1, 0), b3, voffB);
            PG8_BAR; PG8_WAIT_L(0); PG8_MMA(0, 1, At, B1); PG8_BAR;
            PG8_LDA(At, 1, 1); PG8_STAGE(PG8_SA(1, 0), a3, voffA);
            PG8_BAR; PG8_WAIT_L(0); PG8_MMA(1, 0, At, B0); PG8_BAR; PG8_SCHED;
            PG8_STAGE(PG8_SB(1, 1), b3 + hstep, voffB);
            PG8_WAIT_V(6); PG8_BAR; PG8_MMA(1, 1, At, B1); PG8_BAR;
            }
        }
        if constexpr (ALIGN_EPI) { if (wr == 0) PG8_BAR; }
        if constexpr (!Epi::AFTER_DRAIN) { E(acc, cur, wr, wc, fr, fq); S.done(cur); }
        if (!has_next) break;
#pragma unroll
        for (int a = 0; a < 2; ++a)
#pragma unroll
            for (int b = 0; b < 2; ++b)
#pragma unroll
                for (int m = 0; m < 4; ++m)
#pragma unroll
                    for (int n = 0; n < 2; ++n) acc[a][b][m][n] = (f32x4){0.f, 0.f, 0.f, 0.f};
        cur = nxt; cA = nA; cB = nB; ++ui;
        if constexpr (ALIGN_EPI) { if (wr == 1) PG8_BAR; }
    }
    PG8_WAIT_V(0);
    if constexpr (!ALIGN_EPI) { if (wr == 0) PG8_BAR; }
    PG8_BAR;
    if constexpr (Epi::AFTER_DRAIN) { E.fused(acc, cur, wr, wc, fr, fq, lds, wid, lane); S.done(cur); }
#undef PG8_SA
#undef PG8_SB
#undef PG8_STAGE
#undef PG8_LDA
#undef PG8_LDB
#undef PG8_MMA
#undef PG8_WAIT_V
#undef PG8_WAIT_L
#undef PG8_BAR
#undef PG8_SCHED
}
}

#ifndef PHASE_MASK
#define PHASE_MASK 0xFFF
#endif
#ifndef REPEAT_SUB
#define REPEAT_SUB 0
#endif
#ifndef ONE_LAUNCH
#define ONE_LAUNCH 1
#endif
#ifndef FAST_GEMM
#define FAST_GEMM 1
#endif
#ifndef FAST_ATTN
#define FAST_ATTN 1
#endif
#ifndef FAST_HGRN
#define FAST_HGRN 1
#endif

#define GAS __attribute__((address_space(1)))
#define LAS __attribute__((address_space(3)))
typedef unsigned short bf16;
typedef unsigned v4u __attribute__((ext_vector_type(4)));
typedef unsigned v2u __attribute__((ext_vector_type(2)));
typedef float f32x4 __attribute__((ext_vector_type(4)));
typedef float f32x2 __attribute__((ext_vector_type(2)));
typedef float f32x16 __attribute__((ext_vector_type(16)));
typedef short bf16x8 __attribute__((ext_vector_type(8)));
typedef short s16x4 __attribute__((ext_vector_type(4)));
#define LDS_WAIT() asm volatile("s_waitcnt lgkmcnt(0)" ::: "memory")
#define VM_WAIT() asm volatile("s_waitcnt vmcnt(0)" ::: "memory")

constexpr int NB = 4, SEQ = 4096, T = NB * SEQ, DM = 1024, INW = 3584, NE = 32, FF = 256, HW = 512  ;
constexpr int NWAVES = 8, NTHR = 512;
constexpr float EPS = 1e-6f;
constexpr float QSCALE = 0.125f * 1.4426950408889634f;
constexpr int XS_ROWS = 40960;

constexpr size_t MiB = 1u << 20;
constexpr size_t WS_CTL = 0, CTL_ZERO_BYTES = 256 * 1024;
constexpr size_t WS_MOD = 1 * MiB;
constexpr size_t WS_BIAS1 = 1 * MiB + 128 * 1024;
constexpr size_t WS_LB = 1 * MiB + 192 * 1024;
constexpr size_t WS_WRT = 1 * MiB + 256 * 1024;
constexpr size_t WS_WRH = 1 * MiB + 512 * 1024;
constexpr size_t WS_WRL = 1 * MiB + 640 * 1024;
constexpr size_t WS_TOKE = 2 * MiB;
constexpr size_t WS_TOKW = 2 * MiB + 128 * 1024;
constexpr size_t WS_TOKP = 2 * MiB + 256 * 1024;
constexpr size_t WS_ROWINFO = 2 * MiB + 384 * 1024;
constexpr size_t WS_ROWW = 2 * MiB + 576 * 1024;
constexpr size_t WS_WOT = 4 * MiB;
constexpr size_t WS_WB = 6 * MiB;
constexpr size_t WS_XN = 34 * MiB;
constexpr size_t WS_MIXED = WS_XN;
constexpr size_t WS_Y = 6 * MiB;
constexpr size_t WS_WGU = 70 * MiB;
constexpr size_t WS_WD = 102 * MiB;
constexpr size_t WS_Q = 118 * MiB, WS_K = 134 * MiB, WS_V = 150 * MiB, WS_GQ = 166 * MiB, WS_GI = 182 * MiB, WS_GG = 198 * MiB;
constexpr size_t WS_LF = 214 * MiB;
constexpr size_t WS_H2 = 118 * MiB;
constexpr size_t WS_XS = 150 * MiB;
constexpr size_t WS_HM = 230 * MiB;
constexpr size_t WS_END = 256 * MiB;
static_assert(WS_LF + (size_t)T * HW * 4 <= WS_END && WS_HM + (size_t)XS_ROWS * FF * 2 <= WS_END && WS_XS + (size_t)XS_ROWS * DM * 2 <= WS_HM && WS_Y + (size_t)T * 2 * DM * 2 <= WS_WGU, "ws map");
constexpr size_t DO_U = 0, DO_D = 32 * MiB, DO_ONAIVE = 0;
constexpr int CW_CNT = 1024;
constexpr int CW_BAR = 4096;

constexpr int LDS_BYTES = 147456;
constexpr int LDS_CTL_OFF = 131072;
constexpr int LC_TILE_E = 64;
constexpr int LC_NTILES = 60;

struct Params {
    const float* x; const float* c; const int* positions; const float* norm1_w; const float* norm2_w; const float* final_norm_w;
    const float* ada_w; const float* ada_b; const float* w_in; const float* w_out;
    const float* lq1; const float* lk1; const float* lq2; const float* lk2; const float* subln_w;
    const float* hg_lb; const float* hg_norm_w; const float* w_group; const float* b_group; const float* w_router; const float* b_router;
    const float* w_gate; const float* w_up; const float* w_down;
    float* out; unsigned char* ws; int ph_lo, ph_hi;
};

__device__ __forceinline__ unsigned f2bf(float f) { unsigned u = __builtin_bit_cast(unsigned, f); return (u + 0x7fffu + ((u >> 16) & 1u)) >> 16; }
__device__ __forceinline__ unsigned pk2(float lo, float hi) { return f2bf(lo) | (f2bf(hi) << 16); }
__device__ __forceinline__ float bf2f(unsigned short h) { return __builtin_bit_cast(float, (unsigned)h << 16); }
__device__ __forceinline__ float bflo(unsigned w) { return __builtin_bit_cast(float, w << 16); }
__device__ __forceinline__ float bfhi(unsigned w) { return __builtin_bit_cast(float, w & 0xffff0000u); }
__device__ __forceinline__ float wave_sum(float v) {
#pragma unroll
    for (int o = 1; o < 64; o <<= 1) v += __shfl_xor(v, o);
    return v;
}
__device__ __forceinline__ float wave_max(float v) {
#pragma unroll
    for (int o = 1; o < 64; o <<= 1) v = fmaxf(v, __shfl_xor(v, o));
    return v;
}
__device__ __forceinline__ float silu_f(float v) { return v / (1.f + __expf(-v)); }
__device__ __forceinline__ float sigmoid_f(float v) { return 1.f / (1.f + __expf(-v)); }

__device__ __forceinline__ void tile_load(const float* W, int N, int k0, int n0, LAS float* scr, int lane) {
    float tv[32]; const float* wp = W + (size_t)(k0 + (lane >> 5)) * N + n0 + (lane & 31);
#pragma unroll
    for (int i = 0; i < 32; ++i) tv[i] = wp[(size_t)(2 * i) * N];
#pragma unroll
    for (int i = 0; i < 32; ++i) scr[(2 * i + (lane >> 5)) * 33 + (lane & 31)] = tv[i];
    LDS_WAIT(); asm volatile("" ::: "memory");
}
__device__ __forceinline__ void tile_store(const LAS float* scr, bf16* drow0, int K, int k0, int lane, const float* sc) {
    const int c = lane & 7;
#pragma unroll
    for (int j = 0; j < 4; ++j) { const int n = (lane >> 3) + 8 * j; const LAS float* s = scr + (8 * c) * 33 + n;
        v4u o;
        if (sc) { o.x = pk2(s[0 * 33] * sc[0], s[1 * 33] * sc[1]); o.y = pk2(s[2 * 33] * sc[2], s[3 * 33] * sc[3]); o.z = pk2(s[4 * 33] * sc[4], s[5 * 33] * sc[5]); o.w = pk2(s[6 * 33] * sc[6], s[7 * 33] * sc[7]); }
        else { o.x = pk2(s[0 * 33], s[1 * 33]); o.y = pk2(s[2 * 33], s[3 * 33]); o.z = pk2(s[4 * 33], s[5 * 33]); o.w = pk2(s[6 * 33], s[7 * 33]); }
        *(v4u*)(drow0 + (size_t)n * K + k0 + 8 * c) = o; }
}

__device__ __forceinline__ void phase_prep(const Params& P, LAS unsigned char* lds, int vb, int nvb) {
    const int tid = threadIdx.x, lane = tid & 63, wave = tid >> 6;
    unsigned char* ws = P.ws;
    {
        LAS float* cact = (LAS float*)lds;
        LAS float* part = (LAS float*)(lds + 16384);
        bool have = false;
        for (int it = vb; it < 192; it += nvb) {
            if (!have) { for (int i = tid; i < 4096; i += NTHR) cact[i] = silu_f(P.c[i]); have = true; }
            __syncthreads();
            const int cg_ = tid & 7, rg = tid >> 3, e0 = it * 32 + cg_ * 4;
            float acc[4][4];
#pragma unroll
            for (int b = 0; b < 4; ++b)
#pragma unroll
                for (int j = 0; j < 4; ++j) acc[b][j] = 0.f;
#pragma unroll 4
            for (int i = 0; i < 16; ++i) { const int d = rg + 64 * i; const f32x4 w = *(const f32x4*)(P.ada_w + (size_t)d * 6144 + e0);
#pragma unroll
                for (int b = 0; b < 4; ++b) { const float cv = cact[b * 1024 + d]; acc[b][0] += cv * w.x; acc[b][1] += cv * w.y; acc[b][2] += cv * w.z; acc[b][3] += cv * w.w; } }
#pragma unroll
            for (int b = 0; b < 4; ++b)
#pragma unroll
                for (int j = 0; j < 4; ++j) part[(rg * 8 + cg_) * 16 + b * 4 + j] = acc[b][j];
            __syncthreads();
            if (tid < 128) { const int cgi = tid >> 4, bj = tid & 15; float s = 0.f;
                for (int r = 0; r < 64; ++r) s += part[(r * 8 + cgi) * 16 + bj];
                const int b = bj >> 2, e = it * 32 + cgi * 4 + (bj & 3);
                ((float*)(ws + WS_MOD))[b * 6144 + e] = s + P.ada_b[e]; }
            __syncthreads();
        }
    }
    __syncthreads();
    const int gw = vb * NWAVES + wave, NGW = nvb * NWAVES;
    for (int m = gw; m < T; m += NGW) {
        const f32x4* xr = (const f32x4*)(P.x + (size_t)m * DM) + lane;
        f32x4 v[4]; float s = 0.f;
#pragma unroll
        for (int j = 0; j < 4; ++j) { v[j] = xr[64 * j]; s += (v[j].x * v[j].x + v[j].y * v[j].y) + (v[j].z * v[j].z + v[j].w * v[j].w); }
        const float rstd = rsqrtf(wave_sum(s) * (1.f / DM) + EPS);
        unsigned long long* o8 = (unsigned long long*)((bf16*)(ws + WS_XN) + (size_t)m * DM) + lane;
#pragma unroll
        for (int j = 0; j < 4; ++j) o8[64 * j] = (unsigned long long)pk2(v[j].x * rstd, v[j].y * rstd) | ((unsigned long long)pk2(v[j].z * rstd, v[j].w * rstd) << 32);
    }
    {
        LAS float* scr = (LAS float*)(lds + wave * 16384);
        for (int it = gw; it < 16 * 32; it += NGW) { const int kb = it / 32, nb = it % 32; tile_load(P.w_out, DM, kb * 64, nb * 32, scr, lane);
            tile_store(scr, (bf16*)(ws + WS_WOT) + (size_t)(nb * 32) * DM, DM, kb * 64, lane, nullptr); LDS_WAIT(); asm volatile("" ::: "memory"); }
    }
    for (int i = vb * NTHR + tid; i < 64 * 1024; i += nvb * NTHR) {
        const int n = i >> 10, d = i & 1023; const float w = n < 32 ? P.w_router[d * 32 + n] : n < 36 ? P.w_group[d * 4 + (n - 32)] : 0.f;
        const unsigned hb = f2bf(w); const float lo = w - __builtin_bit_cast(float, hb << 16);
        ((bf16*)(ws + WS_WRH))[i] = (bf16)hb; ((bf16*)(ws + WS_WRL))[i] = (bf16)f2bf(lo); }
    for (int i = vb * NTHR + tid; i < 512 + 36 * 1024; i += nvb * NTHR) {
        if (i < 512) { const float a0 = P.hg_lb[i], a1 = P.hg_lb[512 + i]; ((float*)(ws + WS_LB))[i] = 1.f / (1.f + __expf(a1 - a0)); }
        else { const int q = i - 512, j = q >> 10, d = q & 1023; ((float*)(ws + WS_WRT))[q] = j < 4 ? P.w_group[d * 4 + j] : P.w_router[d * 32 + (j - 4)]; }
    }
}

__device__ __forceinline__ void moe_convert(const Params& P, LAS unsigned char* lds, int gw, int NGW) {
    const int lane = threadIdx.x & 63, wave = threadIdx.x >> 6; unsigned char* ws = P.ws;
    LAS float* scr = (LAS float*)(lds + wave * 16384);
    constexpr int I_G = 16 * 8, I_D = 4 * 32;
    constexpr int NIT = NE * I_G * 2 + NE * I_D;
    for (int it = gw; it < NIT; it += NGW) {
        int r = it;
        if (r < NE * I_G * 2) { const int gu = r / (NE * I_G), rr = r % (NE * I_G), e = rr / I_G, q = rr % I_G, kb = q / 8, nb = q % 8;
            const float* W = (gu ? P.w_up : P.w_gate) + (size_t)e * DM * FF; const int f0 = nb * 32;
            tile_load(W, FF, kb * 64, f0, scr, lane);
            const int row0 = 256 * (f0 >> 7) + 128 * gu + (f0 & 127);
            tile_store(scr, (bf16*)(ws + WS_WGU) + ((size_t)e * 512 + row0) * DM, DM, kb * 64, lane, nullptr); LDS_WAIT(); asm volatile("" ::: "memory"); continue; }
        r -= NE * I_G * 2;
        { const int e = r / I_D, q = r % I_D, kb = q / 32, nb = q % 32;
            tile_load(P.w_down + (size_t)e * FF * DM, DM, kb * 64, nb * 32, scr, lane);
            tile_store(scr, (bf16*)(ws + WS_WD) + ((size_t)e * DM + nb * 32) * FF, FF, kb * 64, lane, nullptr); LDS_WAIT(); asm volatile("" ::: "memory"); }
    }
}

__device__ __forceinline__ void phase_fold(const Params& P, LAS unsigned char* lds, int vb, int nvb) {
    const int tid = threadIdx.x, lane = tid & 63, wave = tid >> 6;
    unsigned char* ws = P.ws; const float* mod = (const float*)(ws + WS_MOD);
    const int gw = vb * NWAVES + wave, NGW = nvb * NWAVES;
    LAS float* scr = (LAS float*)(lds + wave * 16384);
    for (int it = gw; it < 16 * 112; it += NGW) {
        const int kb = it / 112, nb = it % 112, k0 = kb * 64, n0 = nb * 32;
        tile_load(P.w_in, INW, k0, n0, scr, lane);
        const int c = lane & 7;
#pragma unroll 1
        for (int b = 0; b < 4; ++b) { float sc[8];
#pragma unroll
            for (int j = 0; j < 8; ++j) { const int k = k0 + 8 * c + j; sc[j] = P.norm1_w[k] * (1.f + mod[b * 6144 + 1024 + k]); }
            tile_store(scr, (bf16*)(ws + WS_WB) + ((size_t)b * INW + n0) * DM, DM, k0, lane, sc); }
        LDS_WAIT(); asm volatile("" ::: "memory");
    }
    __syncthreads();
    LAS float* red = (LAS float*)lds;
    for (int it = vb; it < 56; it += nvb) {
        const int n = it * 64 + lane; float a[4] = {0.f, 0.f, 0.f, 0.f};
#pragma unroll 8
        for (int i = 0; i < 128; ++i) { const int k = wave * 128 + i; const float w = P.w_in[(size_t)k * INW + n];
#pragma unroll
            for (int b = 0; b < 4; ++b) a[b] += mod[b * 6144 + k] * w; }
#pragma unroll
        for (int b = 0; b < 4; ++b) red[(wave * 4 + b) * 64 + lane] = a[b];
        __syncthreads();
        if (tid < 256) { const int b = tid >> 6; float s = 0.f;
#pragma unroll
            for (int w8 = 0; w8 < 8; ++w8) s += red[(w8 * 4 + b) * 64 + lane];
            ((float*)(ws + WS_BIAS1))[b * INW + n] = s; }
        __syncthreads();
    }
}

__device__ __forceinline__ void proj_finish(const Params& P, int r, int c0, float* v, const float* pv) {
    unsigned char* ws = P.ws;
    const int b = r >> 12, region = c0 >> 9, cc = c0 & 511;
    const float* bias = (const float*)(ws + WS_BIAS1) + b * INW;
    {   const f32x4 b0 = *(const f32x4*)(bias + c0), b1 = *(const f32x4*)(bias + c0 + 4);
        v[0] += b0.x; v[1] += b0.y; v[2] += b0.z; v[3] += b0.w; v[4] += b1.x; v[5] += b1.y; v[6] += b1.z; v[7] += b1.w; }
    if (region < 2) {
        const int d0 = c0 & 63;
        if (d0 < 16) {
            const f32x4 q0 = *(const f32x4*)(bias + (c0 ^ 8)), q1 = *(const f32x4*)(bias + (c0 ^ 8) + 4);
            const float pb[8] = {q0.x, q0.y, q0.z, q0.w, q1.x, q1.y, q1.z, q1.w};
            const float pos = (float)P.positions[r];
            const float invf[8] = {1.0f, 0.19392274474868576f, 0.03760603093086393f, 0.007292664737217109f, 0.001414213562373095f, 0.0002742481756762073f, 5.318295896944988e-05f, 1.031338537721246e-05f};
            const float sgn = d0 < 8 ? -1.f : 1.f;
#pragma unroll
            for (int j = 0; j < 8; ++j) { const float ang = pos * invf[j]; float rev = ang * 0.15915494309189535f; rev = rev - floorf(rev);
                const float sn = __builtin_amdgcn_sinf(rev), cs = __builtin_amdgcn_cosf(rev);
                v[j] = v[j] * cs + sgn * (pv[j] + pb[j]) * sn; }
        }
        const float sc = region == 0 ? QSCALE : 1.f;
        v4u o; o.x = pk2(v[0] * sc, v[1] * sc); o.y = pk2(v[2] * sc, v[3] * sc); o.z = pk2(v[4] * sc, v[5] * sc); o.w = pk2(v[6] * sc, v[7] * sc);
        *(v4u*)((bf16*)(ws + (region == 0 ? WS_Q : WS_K)) + (size_t)r * HW + cc) = o;
    } else if (region == 4) {
        const float* lb = (const float*)(ws + WS_LB) + cc; float o[8];
#pragma unroll
        for (int j = 0; j < 8; ++j) { const float l = lb[j]; o[j] = __logf(l + (1.f - l) * sigmoid_f(v[j])); }
        float* dst = (float*)(ws + WS_LF) + (size_t)r * HW + cc;
        *(f32x4*)dst = (f32x4){o[0], o[1], o[2], o[3]}; *(f32x4*)(dst + 4) = (f32x4){o[4], o[5], o[6], o[7]};
    } else {
        if (region == 3 || region == 6) {
#pragma unroll
            for (int j = 0; j < 8; ++j) v[j] = silu_f(v[j]); }
        const size_t off = region == 2 ? WS_V : region == 3 ? WS_GQ : region == 5 ? WS_GI : WS_GG;
        v4u o; o.x = pk2(v[0], v[1]); o.y = pk2(v[2], v[3]); o.z = pk2(v[4], v[5]); o.w = pk2(v[6], v[7]);
        *(v4u*)((bf16*)(ws + off) + (size_t)r * HW + cc) = o;
    }
}
__device__ __forceinline__ void outproj_finish(const Params& P, int r, int c0, const float* v) {
    const int b = r >> 12; const float* g1 = (const float*)(P.ws + WS_MOD) + b * 6144 + 2048 + c0;
    const float* xr = P.x + (size_t)r * DM + c0; float* o = P.out + (size_t)r * DM + c0;
    const f32x4 x0 = *(const f32x4*)xr, x1 = *(const f32x4*)(xr + 4), g0 = *(const f32x4*)g1, g4 = *(const f32x4*)(g1 + 4);
    *(f32x4*)o = (f32x4){x0.x + g0.x * v[0], x0.y + g0.y * v[1], x0.z + g0.z * v[2], x0.w + g0.w * v[3]};
    *(f32x4*)(o + 4) = (f32x4){x1.x + g4.x * v[4], x1.y + g4.y * v[5], x1.z + g4.z * v[6], x1.w + g4.w * v[7]};
}
__device__ __forceinline__ void gateup_finish(const Params& P, int rs, int f0, const float* g, const float* u) {
    const float w = ((const float*)(P.ws + WS_ROWW))[rs]; float h[8];
#pragma unroll
    for (int j = 0; j < 8; ++j) h[j] = silu_f(g[j]) * u[j] * w;
    v4u o; o.x = pk2(h[0], h[1]); o.y = pk2(h[2], h[3]); o.z = pk2(h[4], h[5]); o.w = pk2(h[6], h[7]);
    *(v4u*)((bf16*)(P.ws + WS_HM) + (size_t)rs * FF + f0) = o;
}
__device__ __forceinline__ void down_finish(const Params& P, int rs, int c0, const float* v) {
    const int dest = ((const int*)(P.ws + WS_ROWINFO))[rs];
    if (dest >= 0) { v4u o; o.x = pk2(v[0], v[1]); o.y = pk2(v[2], v[3]); o.z = pk2(v[4], v[5]); o.w = pk2(v[6], v[7]);
        *(v4u*)((bf16*)(P.ws + WS_Y) + (size_t)dest * DM + c0) = o; }
}

template <class BRow, class Fin>
__device__ __forceinline__ void naive_gemm(const bf16* A, int M, int N, int K, const BRow& brow, const Fin& fin, int vb, int nvb) {
    const long total = (long)M * (N / 16);
    for (long i = (long)vb * NTHR + threadIdx.x; i < total; i += (long)nvb * NTHR) {
        const int r = (int)(i / (N / 16)), c16 = (int)(i % (N / 16)) * 16;
        float acc[16];
#pragma unroll
        for (int j = 0; j < 16; ++j) acc[j] = 0.f;
        const bf16* a = A + (size_t)r * K;
        for (int k = 0; k < K; k += 8) {
            const v4u av = *(const v4u*)(a + k);
            const float af[8] = {bflo(av.x), bfhi(av.x), bflo(av.y), bfhi(av.y), bflo(av.z), bfhi(av.z), bflo(av.w), bfhi(av.w)};
#pragma unroll
            for (int j = 0; j < 16; ++j) { const v4u bv = *(const v4u*)(brow(r, c16 + j) + k);
                acc[j] += af[0] * bflo(bv.x) + af[1] * bfhi(bv.x) + af[2] * bflo(bv.y) + af[3] * bfhi(bv.y) + af[4] * bflo(bv.z) + af[5] * bfhi(bv.z) + af[6] * bflo(bv.w) + af[7] * bfhi(bv.w); }
        }
        fin(r, c16, acc);
    }
}

struct EpiProj {
    static constexpr bool PERM = true, AFTER_DRAIN = false;
    Params P;
    __device__ __forceinline__ void operator()(const pg8::f32x4 (&acc)[2][2][4][2], const pg8::Unit& u, int wr, int wc, int fr, int fq) const {
        const int pnl = u.pn % 14; const bool rot = (pnl < 4) && !(wc & 1);
#pragma unroll
        for (int ai = 0; ai < 2; ++ai)
#pragma unroll
            for (int m = 0; m < 4; ++m) { const int r = u.pm * 256 + ai * 128 + wr * 64 + m * 16 + fr;
#pragma unroll
                for (int bj = 0; bj < 2; ++bj) { const int c0 = pnl * 256 + bj * 128 + wc * 32 + 8 * fq;
                    float v[8], pv[8];
#pragma unroll
                    for (int n = 0; n < 2; ++n)
#pragma unroll
                        for (int j = 0; j < 4; ++j) v[n * 4 + j] = acc[ai][bj][m][n][j];
                    if (rot) {
#pragma unroll
                        for (int j = 0; j < 8; ++j) pv[j] = __shfl_xor(v[j], 16); }
                    else {
#pragma unroll
                        for (int j = 0; j < 8; ++j) pv[j] = 0.f; }
                    proj_finish(P, r, c0, v, pv); } }
    }
};
struct EpiOut {
    static constexpr bool PERM = true, AFTER_DRAIN = false;
    Params P;
    __device__ __forceinline__ void operator()(const pg8::f32x4 (&acc)[2][2][4][2], const pg8::Unit& u, int wr, int wc, int fr, int fq) const {
#pragma unroll
        for (int ai = 0; ai < 2; ++ai)
#pragma unroll
            for (int m = 0; m < 4; ++m) { const int r = u.pm * 256 + ai * 128 + wr * 64 + m * 16 + fr;
#pragma unroll
                for (int bj = 0; bj < 2; ++bj) { const int c0 = u.pn * 256 + bj * 128 + wc * 32 + 8 * fq; float v[8];
#pragma unroll
                    for (int n = 0; n < 2; ++n)
#pragma unroll
                        for (int j = 0; j < 4; ++j) v[n * 4 + j] = acc[ai][bj][m][n][j];
                    outproj_finish(P, r, c0, v); } }
    }
};
struct EpiGateUp {
    static constexpr bool PERM = true, AFTER_DRAIN = false;
    Params P;
    __device__ __forceinline__ void operator()(const pg8::f32x4 (&acc)[2][2][4][2], const pg8::Unit& u, int wr, int wc, int fr, int fq) const {
        const int pnl = u.pn & 1;
#pragma unroll
        for (int ai = 0; ai < 2; ++ai)
#pragma unroll
            for (int m = 0; m < 4; ++m) { const int rs = u.pm * 256 + ai * 128 + wr * 64 + m * 16 + fr; float g[8], up[8];
#pragma unroll
                for (int n = 0; n < 2; ++n)
#pragma unroll
                    for (int j = 0; j < 4; ++j) { g[n * 4 + j] = acc[ai][0][m][n][j]; up[n * 4 + j] = acc[ai][1][m][n][j]; }
                gateup_finish(P, rs, pnl * 128 + wc * 32 + 8 * fq, g, up); }
    }
};
struct EpiDown {
    static constexpr bool PERM = true, AFTER_DRAIN = false;
    Params P;
    __device__ __forceinline__ void operator()(const pg8::f32x4 (&acc)[2][2][4][2], const pg8::Unit& u, int wr, int wc, int fr, int fq) const {
        const int pnl = u.pn & 3;
#pragma unroll
        for (int ai = 0; ai < 2; ++ai)
#pragma unroll
            for (int m = 0; m < 4; ++m) { const int rs = u.pm * 256 + ai * 128 + wr * 64 + m * 16 + fr;
#pragma unroll
                for (int bj = 0; bj < 2; ++bj) { const int c0 = pnl * 256 + bj * 128 + wc * 32 + 8 * fq; float v[8];
#pragma unroll
                    for (int n = 0; n < 2; ++n)
#pragma unroll
                        for (int j = 0; j < 4; ++j) v[n * 4 + j] = acc[ai][bj][m][n][j];
                    down_finish(P, rs, c0, v); }
                asm volatile("" ::: "memory"); }
    }
};
struct BatchOrder {
    pg8::StaticOrder so;
    __device__ bool next(int i, pg8::Unit& u) const { if (!so.next(i, u)) return false; u.pn += (u.pm >> 4) * 14; return true; }
    __device__ __forceinline__ void a_ready(const pg8::Unit&) const {}
    __device__ __forceinline__ void done(const pg8::Unit&) const {}
};
struct GroupOrder {
    const LAS int* tile_e; int ntiles, NTN, G, c;
    __device__ bool next(int i, pg8::Unit& u) const {
        const int L = i * G + c; if (L >= ntiles * NTN) return false;
        const int rt = L / NTN, j = L % NTN; const int e = __builtin_amdgcn_readfirstlane(tile_e[rt]);
        u.pm = rt; u.pn = e * NTN + j; return true; }
    __device__ __forceinline__ void a_ready(const pg8::Unit&) const {}
    __device__ __forceinline__ void done(const pg8::Unit&) const {}
};

__device__ __forceinline__ int build_tiles(const Params& P, LAS unsigned char* lds) {
    LAS int* lc = (LAS int*)(lds + LDS_CTL_OFF);
    __syncthreads();
    if (threadIdx.x == 0) { const int* cnt = (const int*)(P.ws + WS_CTL) + CW_CNT; int t = 0;
        for (int e = 0; e < NE; ++e) { const int n = (__hip_atomic_load(cnt + e, __ATOMIC_RELAXED, __HIP_MEMORY_SCOPE_AGENT) + 255) >> 8; for (int j = 0; j < n; ++j) lc[LC_TILE_E + t + j] = e; t += n; }
        lc[LC_NTILES] = t; }
    __syncthreads();
    return lc[LC_NTILES];
}

__device__ __forceinline__ void phase_gemm1(const Params& P, LAS unsigned char* lds, int vb, int nvb) {
    unsigned char* ws = P.ws;
#if FAST_GEMM
    pg8::Gemm g{(const bf16*)(ws + WS_XN), (const bf16*)(ws + WS_WB), T, INW, DM}; BatchOrder S; S.so.init(T, INW, nvb, vb);
    EpiProj E{P};
    pg8::gemm_phase<EpiProj, BatchOrder, true, true>(lds, g, S, E);
    {
        const int nun = (T / 256) * (INW / 256), rem = nun % nvb, first = rem ? rem : 0, nconv = nvb - first;
        __syncthreads();
        if (vb >= first) moe_convert(P, lds, (vb - first) * NWAVES + (threadIdx.x >> 6), nconv * NWAVES);
    }
#else
    const bf16* WB = (const bf16*)(ws + WS_WB);
    naive_gemm((const bf16*)(ws + WS_XN), T, INW, DM,
        [&](int r, int n) { return WB + ((size_t)(r >> 12) * INW + n) * DM; },
        [&](int r, int c16, float* acc) { float pv[8];
#pragma unroll
            for (int j = 0; j < 8; ++j) pv[j] = acc[8 + j];
            float v0[8];
#pragma unroll
            for (int j = 0; j < 8; ++j) v0[j] = acc[j];
            proj_finish(P, r, c16, acc, pv); proj_finish(P, r, c16 + 8, acc + 8, v0); }, vb, nvb);
#endif
}
__device__ __forceinline__ void phase_outproj(const Params& P, LAS unsigned char* lds, int vb, int nvb) {
    unsigned char* ws = P.ws;
#if FAST_GEMM
    pg8::Gemm g{(const bf16*)(ws + WS_MIXED), (const bf16*)(ws + WS_WOT), T, DM, DM}; pg8::StaticOrder S; S.init(T, DM, nvb, vb);
    EpiOut E{P};
    pg8::gemm_phase<EpiOut, pg8::StaticOrder, true, true>(lds, g, S, E);
#else
    const bf16* W = (const bf16*)(ws + WS_WOT);
    naive_gemm((const bf16*)(ws + WS_MIXED), T, DM, DM, [&](int r, int n) { return W + (size_t)n * DM; },
        [&](int r, int c16, float* acc) { outproj_finish(P, r, c16, acc); outproj_finish(P, r, c16 + 8, acc + 8); }, vb, nvb);
#endif
}
__device__ __forceinline__ void phase_gateup(const Params& P, LAS unsigned char* lds, int vb, int nvb) {
    unsigned char* ws = P.ws;
    const int ntiles = build_tiles(P, lds);
#if FAST_GEMM
    pg8::Gemm g{(const bf16*)(ws + WS_XS), (const bf16*)(ws + WS_WGU), XS_ROWS, NE * 512, DM};
    GroupOrder S{(const LAS int*)(lds + LDS_CTL_OFF) + LC_TILE_E, ntiles, 2, nvb, vb};
    EpiGateUp E{P};
    pg8::gemm_phase<EpiGateUp, GroupOrder, true, true>(lds, g, S, E);
#else
    const LAS int* te = (const LAS int*)(lds + LDS_CTL_OFF) + LC_TILE_E; const bf16* W = (const bf16*)(ws + WS_WGU);
    const long total = (long)ntiles * 256 * 16;
    for (long i = (long)vb * NTHR + threadIdx.x; i < total; i += (long)nvb * NTHR) {
        const int rs = (int)(i / 16), f16 = (int)(i % 16) * 16, e = te[rs >> 8];
        float g[16], u[16];
#pragma unroll
        for (int j = 0; j < 16; ++j) { g[j] = 0.f; u[j] = 0.f; }
        const bf16* a = (const bf16*)(ws + WS_XS) + (size_t)rs * DM;
        for (int k = 0; k < DM; k += 8) { const v4u av = *(const v4u*)(a + k);
            const float af[8] = {bflo(av.x), bfhi(av.x), bflo(av.y), bfhi(av.y), bflo(av.z), bfhi(av.z), bflo(av.w), bfhi(av.w)};
#pragma unroll
            for (int j = 0; j < 16; ++j) { const int f = f16 + j; const int rowg = 256 * (f >> 7) + (f & 127);
                const v4u bg = *(const v4u*)(W + ((size_t)e * 512 + rowg) * DM + k), bu = *(const v4u*)(W + ((size_t)e * 512 + rowg + 128) * DM + k);
                g[j] += af[0] * bflo(bg.x) + af[1] * bfhi(bg.x) + af[2] * bflo(bg.y) + af[3] * bfhi(bg.y) + af[4] * bflo(bg.z) + af[5] * bfhi(bg.z) + af[6] * bflo(bg.w) + af[7] * bfhi(bg.w);
                u[j] += af[0] * bflo(bu.x) + af[1] * bfhi(bu.x) + af[2] * bflo(bu.y) + af[3] * bfhi(bu.y) + af[4] * bflo(bu.z) + af[5] * bfhi(bu.z) + af[6] * bflo(bu.w) + af[7] * bfhi(bu.w); } }
        gateup_finish(P, rs, f16, g, u); gateup_finish(P, rs, f16 + 8, g + 8, u + 8);
    }
#endif
}
__device__ __forceinline__ void phase_down(const Params& P, LAS unsigned char* lds, int vb, int nvb) {
    unsigned char* ws = P.ws;
    const int ntiles = build_tiles(P, lds);
#if FAST_GEMM
    pg8::Gemm g{(const bf16*)(ws + WS_HM), (const bf16*)(ws + WS_WD), XS_ROWS, NE * DM, FF + P.ph_lo};
    GroupOrder S{(const LAS int*)(lds + LDS_CTL_OFF) + LC_TILE_E, ntiles, 4, nvb, vb};
    EpiDown E{P};
    pg8::gemm_phase<EpiDown, GroupOrder, true, true>(lds, g, S, E);
#else
    const LAS int* te = (const LAS int*)(lds + LDS_CTL_OFF) + LC_TILE_E; const bf16* W = (const bf16*)(ws + WS_WD);
    naive_gemm((const bf16*)(ws + WS_HM), ntiles * 256, DM, FF, [&](int r, int n) { return W + ((size_t)te[r >> 8] * DM + n) * FF; },
        [&](int r, int c16, float* acc) { down_finish(P, r, c16, acc); down_finish(P, r, c16 + 8, acc + 8); }, vb, nvb);
#endif
}

__device__ __forceinline__ float diff_lambda(const Params& P, int lane) {
    const float s1 = wave_sum(P.lq1[lane] * P.lk1[lane]), s2 = wave_sum(P.lq2[lane] * P.lk2[lane]);
    return __expf(s1) - __expf(s2) + 0.2f;
}
__device__ __forceinline__ void naive_attn(const Params& P, LAS unsigned char* lds, int vb, int nvb) {
    const int tid = threadIdx.x, lane = tid & 63, wave = tid >> 6; unsigned char* ws = P.ws;
    const bf16* Q = (const bf16*)(ws + WS_Q); const bf16* K = (const bf16*)(ws + WS_K); const bf16* V = (const bf16*)(ws + WS_V); bf16* MX = (bf16*)(ws + WS_MIXED);
    LAS float* qs = (LAS float*)(lds + wave * 512);
    const float lam = diff_lambda(P, lane);
    for (int task = vb * NWAVES + wave; task < NB * 4 * SEQ; task += nvb * NWAVES) {
        const int q = task % SEQ, bh = task / SEQ, h = bh & 3, b = bh >> 2; const size_t row = (size_t)b * SEQ + q;
        { const unsigned w = *(const unsigned*)(Q + row * HW + h * 128 + 2 * lane); qs[2 * lane] = bflo(w); qs[2 * lane + 1] = bfhi(w); }
        LDS_WAIT(); asm volatile("" ::: "memory");
        float m0 = -INFINITY, m1 = -INFINITY, l0 = 0.f, l1 = 0.f, o00 = 0.f, o01 = 0.f, o10 = 0.f, o11 = 0.f;
        for (int kc = 0; kc * 64 <= q; ++kc) {
            const int key = kc * 64 + lane; const bool valid = key <= q;
            const bf16* kr = K + ((size_t)b * SEQ + key) * HW + h * 128; float s0 = 0.f, s1 = 0.f;
#pragma unroll
            for (int d = 0; d < 64; d += 8) { const v4u a = *(const v4u*)(kr + d), c2 = *(const v4u*)(kr + 64 + d);
                s0 += qs[d] * bflo(a.x) + qs[d + 1] * bfhi(a.x) + qs[d + 2] * bflo(a.y) + qs[d + 3] * bfhi(a.y) + qs[d + 4] * bflo(a.z) + qs[d + 5] * bfhi(a.z) + qs[d + 6] * bflo(a.w) + qs[d + 7] * bfhi(a.w);
                s1 += qs[64 + d] * bflo(c2.x) + qs[65 + d] * bfhi(c2.x) + qs[66 + d] * bflo(c2.y) + qs[67 + d] * bfhi(c2.y) + qs[68 + d] * bflo(c2.z) + qs[69 + d] * bfhi(c2.z) + qs[70 + d] * bflo(c2.w) + qs[71 + d] * bfhi(c2.w); }
            if (!valid) { s0 = -INFINITY; s1 = -INFINITY; }
            const float n0 = fmaxf(m0, wave_max(s0)), n1 = fmaxf(m1, wave_max(s1));
            const float p0 = valid ? exp2f(s0 - n0) : 0.f, p1 = valid ? exp2f(s1 - n1) : 0.f;
            const float a0 = exp2f(m0 - n0), a1 = exp2f(m1 - n1);
            l0 = l0 * a0 + wave_sum(p0); l1 = l1 * a1 + wave_sum(p1); o00 *= a0; o01 *= a0; o10 *= a1; o11 *= a1; m0 = n0; m1 = n1;
            const bf16* vr = V + ((size_t)b * SEQ + kc * 64) * HW + h * 128 + 2 * lane;
            for (int kk = 0; kk < 64; ++kk) { const float pa = __shfl(p0, kk), pb = __shfl(p1, kk); const unsigned w = *(const unsigned*)(vr + (size_t)kk * HW);
                const float va = bflo(w), vb2 = bfhi(w); o00 += pa * va; o01 += pa * vb2; o10 += pb * va; o11 += pb * vb2; }
        }
        const float r0 = o00 / l0 - lam * o10 / l1, r1 = o01 / l0 - lam * o11 / l1;
        const float rstd = rsqrtf(wave_sum(r0 * r0 + r1 * r1) * (1.f / 128.f) + EPS);
        *(unsigned*)(MX + row * DM + h * 128 + 2 * lane) = pk2(r0 * rstd * P.subln_w[2 * lane] * 0.8f, r1 * rstd * P.subln_w[2 * lane + 1] * 0.8f);
        asm volatile("" ::: "memory");
    }
}
__device__ __forceinline__ void naive_hgrn_rec(const Params& P, int vb, int nvb) {
    const int tid = threadIdx.x; unsigned char* ws = P.ws;
    const bf16* GQ = (const bf16*)(ws + WS_GQ); const bf16* GI = (const bf16*)(ws + WS_GI); const float* LF = (const float*)(ws + WS_LF);
    float* OB = (float*)((unsigned char*)P.out + DO_ONAIVE);
    for (int grp = vb * 4 + (tid >> 7); grp < 16; grp += nvb * 4) {
        const int b = grp >> 2, h = grp & 3, v = tid & 127;
        float S[128];
#pragma unroll
        for (int k = 0; k < 128; ++k) S[k] = 0.f;
        for (int t = 0; t < SEQ; ++t) {
            const size_t base = ((size_t)b * SEQ + t) * HW + h * 128;
            const float vv = bf2f(GI[base + v]); float o = 0.f;
#pragma unroll
            for (int k = 0; k < 128; k += 4) { const f32x4 lf = *(const f32x4*)(LF + base + k); const v2u qw = *(const v2u*)(GQ + base + k);
                const float f0 = __expf(lf.x), f1 = __expf(lf.y), f2 = __expf(lf.z), f3 = __expf(lf.w);
                S[k] = f0 * S[k] + (1.f - f0) * vv; S[k + 1] = f1 * S[k + 1] + (1.f - f1) * vv; S[k + 2] = f2 * S[k + 2] + (1.f - f2) * vv; S[k + 3] = f3 * S[k + 3] + (1.f - f3) * vv;
                o += S[k] * bflo(qw.x) + S[k + 1] * bfhi(qw.x) + S[k + 2] * bflo(qw.y) + S[k + 3] * bfhi(qw.y); }
            OB[base + v] = o;
        }
    }
}
__device__ __forceinline__ void naive_hgrn_norm(const Params& P, int vb, int nvb) {
    const int tid = threadIdx.x, lane = tid & 63, wave = tid >> 6; unsigned char* ws = P.ws;
    const float* OB = (const float*)((unsigned char*)P.out + DO_ONAIVE); const bf16* GG = (const bf16*)(ws + WS_GG); bf16* MX = (bf16*)(ws + WS_MIXED);
    for (int task = vb * NWAVES + wave; task < T * 4; task += nvb * NWAVES) {
        const int row = task >> 2, h = task & 3; const size_t base = (size_t)row * HW + h * 128 + 2 * lane;
        const f32x2 o = *(const f32x2*)(OB + base); const float rstd = rsqrtf(wave_sum(o.x * o.x + o.y * o.y) * (1.f / 128.f) + EPS);
        const unsigned g = *(const unsigned*)(GG + base);
        *(unsigned*)(MX + (size_t)row * DM + 512 + h * 128 + 2 * lane) = pk2(o.x * rstd * P.hg_norm_w[2 * lane] * bflo(g), o.y * rstd * P.hg_norm_w[2 * lane + 1] * bfhi(g));
    }
}

#define MFMA32(a, b, c) __builtin_amdgcn_mfma_f32_32x32x16_bf16((a), (b), (c), 0, 0, 0)
typedef __attribute__((address_space(3))) const char* lds_cptr;
typedef short v4i16_t __attribute__((ext_vector_type(4)));
typedef __bf16 bf16x2_t __attribute__((ext_vector_type(2)));
__device__ __forceinline__ s16x4 vtr(lds_cptr p) { return __builtin_bit_cast(s16x4, __builtin_amdgcn_ds_read_tr16_b64_v4i16((LAS v4i16_t*)p)); }
__device__ __forceinline__ int crow(int i, int hi) { return (i & 3) + 8 * (i >> 2) + 4 * hi; }
__device__ __forceinline__ unsigned cvtpk(float lo, float hi) { f32x2 v = {lo, hi}; bf16x2_t b = __builtin_convertvector(v, bf16x2_t); return __builtin_bit_cast(unsigned, b); }
#define PACK8(x, s) __builtin_bit_cast(bf16x8, (v4u){cvtpk((x)[8 * (s)], (x)[8 * (s) + 1]), cvtpk((x)[8 * (s) + 2], (x)[8 * (s) + 3]), cvtpk((x)[8 * (s) + 4], (x)[8 * (s) + 5]), cvtpk((x)[8 * (s) + 6], (x)[8 * (s) + 7])})
#define VFRAG(lo, hi4) (bf16x8){(lo)[0], (lo)[1], (lo)[2], (lo)[3], (hi4)[0], (hi4)[1], (hi4)[2], (hi4)[3]}
__device__ __forceinline__ void vtile_load(const bf16* g, int pitch, int wave, int lane, v4u (&reg)[2]) {
#pragma unroll
    for (int i = 0; i < 2; ++i) { const int pi = wave + 8 * i; reg[i] = *(const v4u*)(g + (size_t)(16 * (pi & 3) + (lane >> 2)) * pitch + (pi >> 2) * 32 + (lane & 3) * 8); }
}
__device__ __forceinline__ void vtile_store(LAS unsigned char* vbuf, int wave, int lane, const v4u (&reg)[2]) {
#pragma unroll
    for (int i = 0; i < 2; ++i) *(LAS v4u*)(vbuf + (wave + 8 * i) * 1024 + lane * 16) = reg[i];
}
__device__ __forceinline__ void ktile_load(const bf16* g, int pitch, int wave, int lane, v4u (&reg)[2]) {
#pragma unroll
    for (int i = 0; i < 2; ++i) reg[i] = *(const v4u*)(g + (size_t)lane * pitch + (wave + 8 * i) * 8);
}
__device__ __forceinline__ void ktile_store(LAS unsigned char* kbuf, int wave, int lane, const v4u (&reg)[2]) {
#pragma unroll
    for (int i = 0; i < 2; ++i) *(LAS v4u*)(kbuf + (wave + 8 * i) * 1024 + lane * 16) = reg[i];
}

#if FAST_ATTN
#ifndef ATT_THR
#define ATT_THR 8.0f
#endif
__device__ __forceinline__ float max3f(float a, float b, float c) { float r; asm("v_max3_f32 %0, %1, %2, %3" : "=v"(r) : "v"(a), "v"(b), "v"(c)); return r; }
__device__ __forceinline__ float rowmax32(const f32x16& a, const f32x16& b) {
    float m0 = max3f(a[0], a[1], a[2]), m1 = max3f(b[0], b[1], b[2]);
    m0 = max3f(m0, a[3], a[4]); m1 = max3f(m1, b[3], b[4]); m0 = max3f(m0, a[5], a[6]); m1 = max3f(m1, b[5], b[6]); m0 = max3f(m0, a[7], a[8]); m1 = max3f(m1, b[7], b[8]);
    m0 = max3f(m0, a[9], a[10]); m1 = max3f(m1, b[9], b[10]); m0 = max3f(m0, a[11], a[12]); m1 = max3f(m1, b[11], b[12]); m0 = max3f(m0, a[13], a[14]); m1 = max3f(m1, b[13], b[14]);
    m0 = max3f(m0, a[15], b[15]); m0 = max3f(m0, m1, m1);
    return max3f(m0, __shfl_xor(m0, 32), m0);
}
__device__ __forceinline__ void attn_qk(f32x16& s0, f32x16& s1, const f32x16& cinit, LAS unsigned char* kbuf, const bf16x8 (&qf)[4], int m, int hi, int r32) {
#pragma unroll
    for (int ks = 0; ks < 4; ++ks) { lds_cptr kp = (lds_cptr)kbuf + (m * 8 + 2 * ks + hi) * 1024 + r32 * 16;
        const bf16x8 k0 = *(const LAS bf16x8*)kp, k1 = *(const LAS bf16x8*)(kp + 512);
        if (ks == 0) { s0 = MFMA32(k0, qf[0], cinit); s1 = MFMA32(k1, qf[0], cinit); } else { s0 = MFMA32(k0, qf[ks], s0); s1 = MFMA32(k1, qf[ks], s1); } }
}
__device__ __forceinline__ void attn_mask(f32x16& s0, f32x16& s1, int kbase, int rowq, int hi) {
#pragma unroll
    for (int i = 0; i < 16; ++i) { const int key = kbase + crow(i, hi); if (key > rowq) s0[i] = -INFINITY; if (key + 32 > rowq) s1[i] = -INFINITY; }
}
__device__ __forceinline__ void attn_unit(const Params& P, LAS unsigned char* lds, int b, int h, int qb, float lam) {
    const int tid = threadIdx.x, lane = tid & 63, r32 = lane & 31, hi = lane >> 5, wave = __builtin_amdgcn_readfirstlane(tid >> 6), m = wave >> 2, ws4 = wave & 3;
    unsigned char* ws = P.ws;
    const bf16* Kg = (const bf16*)(ws + WS_K) + (size_t)b * SEQ * HW + h * 128; const bf16* Vg = (const bf16*)(ws + WS_V) + (size_t)b * SEQ * HW + h * 128;
    const int q0 = qb * 128, NT = 2 * qb + 2, rowq = q0 + 32 * ws4 + r32, wrow0 = q0 + 32 * ws4;
    bf16x8 qf[4];
    { const bf16* Qg = (const bf16*)(ws + WS_Q) + ((size_t)b * SEQ + rowq) * HW + h * 128 + m * 64 + 8 * hi;
#pragma unroll
      for (int ks = 0; ks < 4; ++ks) qf[ks] = *(const bf16x8*)(Qg + 16 * ks); }
    v4u kr[2], vr[2];
    { v4u k1[2]; ktile_load(Kg, HW, wave, lane, kr); vtile_load(Vg, HW, wave, lane, vr); ktile_load(Kg + (size_t)64 * HW, HW, wave, lane, k1);
      ktile_store(lds, wave, lane, kr); vtile_store(lds + 32768, wave, lane, vr); ktile_store(lds + 16384, wave, lane, k1); }
    __syncthreads();
    f32x16 o[4], cinit, sc0, sc1, sn0, sn1;
#pragma unroll
    for (int i = 0; i < 16; ++i) { cinit[i] = 0.f; sn0[i] = 0.f; sn1[i] = 0.f; }
#pragma unroll
    for (int d = 0; d < 4; ++d)
#pragma unroll
        for (int i = 0; i < 16; ++i) o[d][i] = 0.f;
    attn_qk(sc0, sc1, cinit, lds, qf, m, hi, r32);
    if (63 > wrow0) attn_mask(sc0, sc1, 0, rowq, hi);
    float mref = rowmax32(sc0, sc1), lrun = 0.f;
#pragma unroll
    for (int i = 0; i < 16; ++i) { sc0[i] -= mref; sc1[i] -= mref; cinit[i] = -mref; }
    bool cur_vis = true;
    const int voff = ((lane >> 4) & 1) * 32 + (lane & 3) * 8 + (4 * hi + ((lane & 15) >> 2)) * 64;
    for (int t = 0; t < NT; ++t) {
        const bool more1 = t + 1 < NT, more2 = t + 2 < NT;
        if (more2) ktile_load(Kg + (size_t)(t + 2) * 64 * HW, HW, wave, lane, kr);
        if (more1) vtile_load(Vg + (size_t)(t + 1) * 64 * HW, HW, wave, lane, vr);
        const bool nxt_vis = more1 && (64 * (t + 1) <= wrow0 + 31);
        if (nxt_vis) attn_qk(sn0, sn1, cinit, lds + ((t + 1) & 1) * 16384, qf, m, hi, r32);
        if (cur_vis) {
            float rs = 0.f;
#pragma unroll
            for (int i = 0; i < 16; ++i) { sc0[i] = __builtin_amdgcn_exp2f(sc0[i]); sc1[i] = __builtin_amdgcn_exp2f(sc1[i]); rs += sc0[i] + sc1[i]; }
            lrun += rs;
            lds_cptr vp = (lds_cptr)lds + 32768 + (t & 1) * 16384 + voff;
#pragma unroll
            for (int ks4 = 0; ks4 < 4; ++ks4) {
                const bf16x8 pf = (ks4 == 0) ? PACK8(sc0, 0) : (ks4 == 1) ? PACK8(sc0, 1) : (ks4 == 2) ? PACK8(sc1, 0) : PACK8(sc1, 1);
#pragma unroll
                for (int d = 0; d < 4; ++d) { const s16x4 lo = vtr(vp + d * 4096 + ks4 * 1024), h4 = vtr(vp + d * 4096 + ks4 * 1024 + 512);
                    o[d] = MFMA32(VFRAG(lo, h4), pf, o[d]); } }
        }
        if (nxt_vis) {
            if (64 * (t + 1) + 63 > wrow0) attn_mask(sn0, sn1, 64 * (t + 1), rowq, hi);
            const float mx = rowmax32(sn0, sn1);
            if (__any(mx > ATT_THR)) {
                const float dl = fmaxf(mx, 0.f), al = __builtin_amdgcn_exp2f(-dl); mref += dl; lrun *= al;
#pragma unroll
                for (int d = 0; d < 4; ++d)
#pragma unroll
                    for (int i = 0; i < 16; ++i) o[d][i] *= al;
#pragma unroll
                for (int i = 0; i < 16; ++i) { sn0[i] -= dl; sn1[i] -= dl; cinit[i] = -mref; }
            }
        }
        if (more2) ktile_store(lds + (t & 1) * 16384, wave, lane, kr);
        if (more1) vtile_store(lds + 32768 + ((t + 1) & 1) * 16384, wave, lane, vr);
        __syncthreads();
        sc0 = sn0; sc1 = sn1; cur_vis = nxt_vis;
    }
    lrun += __shfl_xor(lrun, 32);
    const float inv = 1.f / lrun;
    LAS float* xch = (LAS float*)lds + ws4 * 4096;
    if (m == 1) {
#pragma unroll
        for (int d = 0; d < 4; ++d)
#pragma unroll
            for (int i = 0; i < 16; ++i) xch[(d * 16 + i) * 64 + lane] = o[d][i] * inv; }
    __syncthreads();
    if (m == 0) {
        float ss = 0.f;
#pragma unroll
        for (int d = 0; d < 4; ++d)
#pragma unroll
            for (int i = 0; i < 16; ++i) { const float v = o[d][i] * inv - lam * xch[(d * 16 + i) * 64 + lane]; o[d][i] = v; ss += v * v; }
        ss += __shfl_xor(ss, 32);
        const float rstd = rsqrtf(ss * (1.f / 128.f) + EPS) * 0.8f;
        bf16* dst = (bf16*)(ws + WS_MIXED) + ((size_t)b * SEQ + rowq) * DM + h * 128;
#pragma unroll
        for (int d = 0; d < 4; ++d)
#pragma unroll
            for (int g = 0; g < 4; ++g) { const int dv0 = 32 * d + 8 * g + 4 * hi; const f32x4 w = *(const f32x4*)(P.subln_w + dv0);
                v2u pk; pk.x = pk2(o[d][4 * g] * rstd * w.x, o[d][4 * g + 1] * rstd * w.y); pk.y = pk2(o[d][4 * g + 2] * rstd * w.z, o[d][4 * g + 3] * rstd * w.w);
                *(v2u*)(dst + dv0) = pk; }
    }
    __syncthreads();
}
__device__ __forceinline__ void attn_phase(const Params& P, LAS unsigned char* lds, int vb, int nvb) {
    const float lam = diff_lambda(P, threadIdx.x & 63);
    for (int u = vb; u < 256; u += nvb) { const int bh = u >> 4, p = u & 15, b = bh >> 2, h = bh & 3;
        attn_unit(P, lds, b, h, 31 - p, lam); attn_unit(P, lds, b, h, p, lam); }
}
#endif

#if FAST_HGRN
__device__ __forceinline__ void hgrn_pass_a(const Params& P, LAS unsigned char* lds, int vb, int nvb) {
    const int tid = threadIdx.x, lane = tid & 63, r32 = lane & 31, hi = lane >> 5, wave = __builtin_amdgcn_readfirstlane(tid >> 6), k = tid & 127, seg = tid >> 7;
    unsigned char* ws = P.ws;
    LAS float* tot = (LAS float*)lds; LAS unsigned char* ktT = lds + 2048; LAS unsigned char* vimg = lds + 20480;
    const float* LF = (const float*)(ws + WS_LF); const bf16* GI = (const bf16*)(ws + WS_GI);
    bf16* U = (bf16*)((unsigned char*)P.out + DO_U); float* Dd = (float*)((unsigned char*)P.out + DO_D);
    for (int u = vb; u < 1024; u += nvb) {
        const int bh = u >> 6, c = u & 63, b = bh >> 2, h = bh & 3; const size_t row0 = (size_t)b * SEQ + c * 64;
        { v4u vr[2]; vtile_load(GI + row0 * HW + h * 128, HW, wave, lane, vr); vtile_store(vimg, wave, lane, vr); }
        float lf[16], bc[16], run = 0.f;
#pragma unroll
        for (int i = 0; i < 16; ++i) lf[i] = LF[(row0 + seg * 16 + i) * HW + h * 128 + k];
#pragma unroll
        for (int i = 0; i < 16; ++i) { run += lf[i]; bc[i] = run; }
        tot[seg * 128 + k] = run;
        __syncthreads();
        float pre = 0.f, all = 0.f;
#pragma unroll
        for (int s = 0; s < 4; ++s) { const float tv = tot[s * 128 + k]; all += tv; if (s < seg) pre += tv; }
        unsigned w[8];
#pragma unroll
        for (int i = 0; i < 8; ++i) { const float a = (1.f - __expf(lf[2 * i])) * __expf(all - pre - bc[2 * i]), c2 = (1.f - __expf(lf[2 * i + 1])) * __expf(all - pre - bc[2 * i + 1]); w[i] = pk2(a, c2); }
        *(LAS v4u*)(ktT + k * 144 + seg * 32) = (v4u){w[0], w[1], w[2], w[3]}; *(LAS v4u*)(ktT + k * 144 + seg * 32 + 16) = (v4u){w[4], w[5], w[6], w[7]};
        if (seg == 0) Dd[(size_t)u * 128 + k] = __expf(all);
        __syncthreads();
        const int vbk = wave >> 1, kb2 = (wave & 1) * 2;
        f32x16 a0, a1;
#pragma unroll
        for (int i = 0; i < 16; ++i) { a0[i] = 0.f; a1[i] = 0.f; }
        lds_cptr vp = (lds_cptr)vimg + vbk * 4096 + ((lane >> 4) & 1) * 32 + (lane & 3) * 8 + (8 * hi + ((lane & 15) >> 2)) * 64;
#pragma unroll
        for (int s = 0; s < 4; ++s) { const s16x4 lo = vtr(vp + s * 1024), h4 = vtr(vp + s * 1024 + 256); const bf16x8 vf = VFRAG(lo, h4);
            const bf16x8 k0 = *(const LAS bf16x8*)(ktT + (32 * kb2 + r32) * 144 + (16 * s + 8 * hi) * 2), k1 = *(const LAS bf16x8*)(ktT + (32 * kb2 + 32 + r32) * 144 + (16 * s + 8 * hi) * 2);
            a0 = MFMA32(vf, k0, a0); a1 = MFMA32(vf, k1, a1); }
        bf16* Ub = U + (size_t)u * 16384;
#pragma unroll
        for (int i = 0; i < 16; ++i) { const int v = 32 * vbk + crow(i, hi); Ub[v * 128 + 32 * kb2 + r32] = (bf16)f2bf(a0[i]); Ub[v * 128 + 32 * kb2 + 32 + r32] = (bf16)f2bf(a1[i]); }
        __syncthreads();
    }
}
__device__ __forceinline__ void hgrn_pass_b(const Params& P, int vb, int nvb) {
    unsigned* U = (unsigned*)((unsigned char*)P.out + DO_U); const float* Dd = (const float*)((unsigned char*)P.out + DO_D);
    for (int idx = vb * NTHR + threadIdx.x; idx < 16 * 128 * 64; idx += nvb * NTHR) {
        const int bh = idx >> 13, rem = idx & 8191, v = rem >> 6, kp = rem & 63;
        unsigned* up = U + (size_t)bh * 64 * 8192 + v * 64 + kp; const float* dp = Dd + (size_t)bh * 64 * 128 + 2 * kp;
        float s0 = 0.f, s1 = 0.f;
#pragma unroll 8
        for (int c = 0; c < 64; ++c) { const unsigned w = up[(size_t)c * 8192]; const f32x2 d = *(const f32x2*)(dp + c * 128);
            up[(size_t)c * 8192] = pk2(s0, s1); s0 = d.x * s0 + bflo(w); s1 = d.y * s1 + bfhi(w); }
    }
}
__device__ __forceinline__ void hgrn_pass_c(const Params& P, LAS unsigned char* lds, int vb, int nvb) {
    const int tid = threadIdx.x, lane = tid & 63, r32 = lane & 31, hi = lane >> 5, wave = __builtin_amdgcn_readfirstlane(tid >> 6), k = tid & 127, seg = tid >> 7;
    unsigned char* ws = P.ws;
    LAS float* tot = (LAS float*)lds; LAS float* part = (LAS float*)(lds + 2048); LAS unsigned char* qt = lds + 4096; LAS unsigned char* kh = lds + 21504; LAS unsigned char* vimg = lds + 38912;
    const float* LF = (const float*)(ws + WS_LF); const bf16* GI = (const bf16*)(ws + WS_GI); const bf16* GQ = (const bf16*)(ws + WS_GQ); const bf16* GG = (const bf16*)(ws + WS_GG);
    const bf16* U = (const bf16*)((unsigned char*)P.out + DO_U); bf16* MX = (bf16*)(ws + WS_MIXED);
    for (int u = vb; u < 1024; u += nvb) {
        const int bh = u >> 6, c = u & 63, b = bh >> 2, h = bh & 3; const size_t row0 = (size_t)b * SEQ + c * 64;
        { v4u vr[2]; vtile_load(GI + row0 * HW + h * 128, HW, wave, lane, vr); vtile_store(vimg, wave, lane, vr); }
        float lf[16], bc[16], run = 0.f; unsigned short qv[16];
#pragma unroll
        for (int i = 0; i < 16; ++i) { lf[i] = LF[(row0 + seg * 16 + i) * HW + h * 128 + k]; qv[i] = GQ[(row0 + seg * 16 + i) * HW + h * 128 + k]; }
#pragma unroll
        for (int i = 0; i < 16; ++i) { run += lf[i]; bc[i] = run; }
        tot[seg * 128 + k] = run;
        __syncthreads();
        float pre = 0.f;
#pragma unroll
        for (int s = 0; s < 3; ++s) { const float tv = tot[s * 128 + k]; if (s < seg) pre += tv; }
#pragma unroll
        for (int i = 0; i < 16; ++i) { const int t = seg * 16 + i; const float bb = pre + bc[i];
            *(LAS unsigned short*)(qt + t * 272 + k * 2) = (unsigned short)f2bf(bf2f(qv[i]) * __expf(bb));
            *(LAS unsigned short*)(kh + t * 272 + k * 2) = (unsigned short)f2bf((1.f - __expf(lf[i])) * __expf(-bb)); }
        __syncthreads();
        const int vbk = wave >> 1, tb = wave & 1;
        f32x16 acc;
#pragma unroll
        for (int i = 0; i < 16; ++i) acc[i] = 0.f;
        bf16x8 bq[8];
        { const bf16* Sg = U + (size_t)u * 16384 + (32 * vbk + r32) * 128 + 8 * hi;
#pragma unroll
          for (int ks = 0; ks < 8; ++ks) { const bf16x8 a = *(const bf16x8*)(Sg + 16 * ks); bq[ks] = *(const LAS bf16x8*)(qt + (32 * tb + r32) * 272 + (16 * ks + 8 * hi) * 2); acc = MFMA32(a, bq[ks], acc); } }
        for (int sb = 0; sb <= tb; ++sb) {
            f32x16 sc;
#pragma unroll
            for (int i = 0; i < 16; ++i) sc[i] = 0.f;
#pragma unroll
            for (int ks = 0; ks < 8; ++ks) { const bf16x8 kf = *(const LAS bf16x8*)(kh + (32 * sb + r32) * 272 + (16 * ks + 8 * hi) * 2); sc = MFMA32(kf, bq[ks], sc); }
            if (sb == tb) {
#pragma unroll
                for (int i = 0; i < 16; ++i) if (crow(i, hi) > r32) sc[i] = 0.f; }
            lds_cptr vp = (lds_cptr)vimg + vbk * 4096 + ((lane >> 4) & 1) * 32 + (lane & 3) * 8 + (32 * sb + 4 * hi + ((lane & 15) >> 2)) * 64;
            { const bf16x8 pf = PACK8(sc, 0); const s16x4 lo = vtr(vp), h4 = vtr(vp + 512); acc = MFMA32(VFRAG(lo, h4), pf, acc); }
            { const bf16x8 pf = PACK8(sc, 1); const s16x4 lo = vtr(vp + 1024), h4 = vtr(vp + 1024 + 512); acc = MFMA32(VFRAG(lo, h4), pf, acc); }
        }
        float ss = 0.f;
#pragma unroll
        for (int i = 0; i < 16; ++i) ss += acc[i] * acc[i];
        ss += __shfl_xor(ss, 32);
        if (hi == 0) part[vbk * 64 + 32 * tb + r32] = ss;
        __syncthreads();
        const float tss = (part[32 * tb + r32] + part[64 + 32 * tb + r32]) + (part[128 + 32 * tb + r32] + part[192 + 32 * tb + r32]);
        const float rstd = rsqrtf(tss * (1.f / 128.f) + EPS);
        const size_t row = row0 + 32 * tb + r32;
#pragma unroll
        for (int g = 0; g < 4; ++g) { const int v0 = 32 * vbk + 8 * g + 4 * hi; const v2u gg = *(const v2u*)(GG + row * HW + h * 128 + v0); const f32x4 nw = *(const f32x4*)(P.hg_norm_w + v0);
            v2u pk; pk.x = pk2(acc[4 * g] * rstd * nw.x * bflo(gg.x), acc[4 * g + 1] * rstd * nw.y * bfhi(gg.x)); pk.y = pk2(acc[4 * g + 2] * rstd * nw.z * bflo(gg.y), acc[4 * g + 3] * rstd * nw.w * bfhi(gg.y));
            *(v2u*)(MX + row * DM + 512 + h * 128 + v0) = pk; }
        __syncthreads();
    }
}
#endif

__device__ __forceinline__ void phase_mix_a(const Params& P, LAS unsigned char* lds, int vb, int nvb) {
#if FAST_HGRN
    hgrn_pass_a(P, lds, vb, nvb);
#if REPEAT_SUB == 1
    __syncthreads(); hgrn_pass_a(P, lds, vb, nvb);
#endif
#else
    naive_hgrn_rec(P, vb, nvb);
#endif
#if FAST_ATTN
    attn_phase(P, lds, vb, nvb);
#if REPEAT_SUB == 2
    __syncthreads(); attn_phase(P, lds, vb, nvb);
#endif
#else
    naive_attn(P, lds, vb, nvb);
#endif
}
__device__ __forceinline__ void phase_mix_b(const Params& P, LAS unsigned char* lds, int vb, int nvb) {
#if FAST_HGRN
    hgrn_pass_b(P, vb, nvb);
#else
    naive_hgrn_norm(P, vb, nvb);
#endif
}
__device__ __forceinline__ void phase_mix_c(const Params& P, LAS unsigned char* lds, int vb, int nvb) {
#if FAST_HGRN
    hgrn_pass_c(P, lds, vb, nvb);
#endif
}

__device__ __forceinline__ void phase_route(const Params& P, LAS unsigned char* lds, int vb, int nvb) {
    const int tid = threadIdx.x, lane = tid & 63, r32 = lane & 31, hi = lane >> 5, wave = __builtin_amdgcn_readfirstlane(tid >> 6); unsigned char* ws = P.ws;
    const float* mod = (const float*)(ws + WS_MOD); const bf16* WRH = (const bf16*)(ws + WS_WRH); const bf16* WRL = (const bf16*)(ws + WS_WRL);
    int* cnt = (int*)(ws + WS_CTL) + CW_CNT;
    LAS float* part = (LAS float*)lds;
    LAS float* red = (LAS float*)(lds + 1024);
    LAS float* lg = (LAS float*)(lds + 1024 + 65536);
    for (int tile = vb; tile < T / 32; tile += nvb) {
        const int t = tile * 32 + r32, b = (tile * 32) >> 12, kw = 128 * wave + 8 * hi;
        float xs[8][8]; float ss = 0.f;
#pragma unroll
        for (int ks = 0; ks < 8; ++ks) { const float* p = P.out + (size_t)t * DM + kw + 16 * ks; const f32x4 a = *(const f32x4*)p, c2 = *(const f32x4*)(p + 4);
            xs[ks][0] = a.x; xs[ks][1] = a.y; xs[ks][2] = a.z; xs[ks][3] = a.w; xs[ks][4] = c2.x; xs[ks][5] = c2.y; xs[ks][6] = c2.z; xs[ks][7] = c2.w;
            ss += (a.x * a.x + a.y * a.y) + (a.z * a.z + a.w * a.w) + (c2.x * c2.x + c2.y * c2.y) + (c2.z * c2.z + c2.w * c2.w); }
        ss += __shfl_xor(ss, 32);
        if (hi == 0) part[wave * 32 + r32] = ss;
        __syncthreads();
        float tot = 0.f;
#pragma unroll
        for (int w8 = 0; w8 < 8; ++w8) tot += part[w8 * 32 + r32];
        const float rstd = rsqrtf(tot * (1.f / DM) + EPS);
        f32x16 acc0, acc1;
#pragma unroll
        for (int i = 0; i < 16; ++i) { acc0[i] = 0.f; acc1[i] = 0.f; }
#pragma unroll
        for (int ks = 0; ks < 8; ++ks) { const int kk = kw + 16 * ks;
            const f32x4 n0 = *(const f32x4*)(P.norm2_w + kk), n1 = *(const f32x4*)(P.norm2_w + kk + 4), s0 = *(const f32x4*)(mod + b * 6144 + 4096 + kk), s1 = *(const f32x4*)(mod + b * 6144 + 4096 + kk + 4),
                        h0 = *(const f32x4*)(mod + b * 6144 + 3072 + kk), h1 = *(const f32x4*)(mod + b * 6144 + 3072 + kk + 4);
            const float nw[8] = {n0.x, n0.y, n0.z, n0.w, n1.x, n1.y, n1.z, n1.w}, sc[8] = {s0.x, s0.y, s0.z, s0.w, s1.x, s1.y, s1.z, s1.w}, sh[8] = {h0.x, h0.y, h0.z, h0.w, h1.x, h1.y, h1.z, h1.w};
            unsigned hb[8], lb[8];
#pragma unroll
            for (int j = 0; j < 8; ++j) { const float h = xs[ks][j] * rstd * nw[j] * (1.f + sc[j]) + sh[j]; hb[j] = f2bf(h); lb[j] = f2bf(h - __builtin_bit_cast(float, hb[j] << 16)); }
            const v4u bhv = {hb[0] | (hb[1] << 16), hb[2] | (hb[3] << 16), hb[4] | (hb[5] << 16), hb[6] | (hb[7] << 16)}, blv = {lb[0] | (lb[1] << 16), lb[2] | (lb[3] << 16), lb[4] | (lb[5] << 16), lb[6] | (lb[7] << 16)};
            *(v4u*)((bf16*)(ws + WS_H2) + (size_t)t * DM + kk) = bhv;
            const bf16x8 bh = __builtin_bit_cast(bf16x8, bhv), bl = __builtin_bit_cast(bf16x8, blv);
            const bf16x8 a0h = *(const bf16x8*)(WRH + (size_t)r32 * DM + kk), a0l = *(const bf16x8*)(WRL + (size_t)r32 * DM + kk), a1h = *(const bf16x8*)(WRH + (size_t)(32 + r32) * DM + kk), a1l = *(const bf16x8*)(WRL + (size_t)(32 + r32) * DM + kk);
            acc0 = MFMA32(a0h, bh, acc0); acc0 = MFMA32(a0h, bl, acc0); acc0 = MFMA32(a0l, bh, acc0);
            acc1 = MFMA32(a1h, bh, acc1); acc1 = MFMA32(a1h, bl, acc1); acc1 = MFMA32(a1l, bh, acc1); }
#pragma unroll
        for (int i = 0; i < 16; ++i) { red[(wave * 32 + i) * 64 + lane] = acc0[i]; red[(wave * 32 + 16 + i) * 64 + lane] = acc1[i]; }
        __syncthreads();
#pragma unroll
        for (int q = 0; q < 4; ++q) { const int idx = tid + 512 * q, reg = idx >> 6, ln = idx & 63; float s = 0.f;
#pragma unroll
            for (int w8 = 0; w8 < 8; ++w8) s += red[(w8 * 32 + reg) * 64 + ln];
            const int n = (reg >> 4) * 32 + crow(reg & 15, ln >> 5); lg[(ln & 31) * 64 + n] = s; }
        __syncthreads();
        if (tid < 32) {
            const int tk = tile * 32 + tid; const LAS float* L = lg + tid * 64;
            float gl[4];
#pragma unroll
            for (int i = 0; i < 4; ++i) gl[i] = L[32 + i] + P.b_group[i];
            int g = 0; float gm = gl[0];
#pragma unroll
            for (int i = 1; i < 4; ++i) if (gl[i] > gm) { gm = gl[i]; g = i; }
            float gs = 0.f;
#pragma unroll
            for (int i = 0; i < 4; ++i) gs += __expf(gl[i] - gm);
            const float gw_ = 1.f / gs;
            float el[8];
#pragma unroll
            for (int i = 0; i < 8; ++i) el[i] = L[g * 8 + i] + P.b_router[g * 8 + i];
            int i1 = 0; float e1 = el[0];
#pragma unroll
            for (int i = 1; i < 8; ++i) if (el[i] > e1) { e1 = el[i]; i1 = i; }
            int i2 = -1; float e2 = -INFINITY;
#pragma unroll
            for (int i = 0; i < 8; ++i) if (i != i1 && el[i] > e2) { e2 = el[i]; i2 = i; }
            const float w1 = 1.f / (1.f + __expf(e2 - e1)), w2 = 1.f - w1;
            const int ea = g * 8 + i1, eb = g * 8 + i2;
            const int pa = atomicAdd(cnt + ea, 1), pb = atomicAdd(cnt + eb, 1);
            int* te = (int*)(ws + WS_TOKE) + 2 * tk; float* tw = (float*)(ws + WS_TOKW) + 2 * tk; int* tp = (int*)(ws + WS_TOKP) + 2 * tk;
            te[0] = ea; te[1] = eb; tw[0] = w1 * gw_; tw[1] = w2 * gw_; tp[0] = pa; tp[1] = pb;
        }
        __syncthreads();
    }
}
__device__ __forceinline__ void phase_scatter(const Params& P, LAS unsigned char* lds, int vb, int nvb) {
    const int tid = threadIdx.x, lane = tid & 63, wave = tid >> 6; unsigned char* ws = P.ws;
    LAS int* off = (LAS int*)(lds + LDS_CTL_OFF) + 256;
    __syncthreads();
    if (tid == 0) { const int* cnt = (const int*)(ws + WS_CTL) + CW_CNT; int o = 0;
        for (int e = 0; e < NE; ++e) { const int n = __hip_atomic_load(cnt + e, __ATOMIC_RELAXED, __HIP_MEMORY_SCOPE_AGENT); off[e] = o; off[40 + e] = n; o += ((n + 255) >> 8) << 8; }
        off[32] = o; }
    __syncthreads();
    int* rinfo = (int*)(ws + WS_ROWINFO); float* roww = (float*)(ws + WS_ROWW); bf16* XS = (bf16*)(ws + WS_XS);
    for (int t = vb * NWAVES + wave; t < T; t += nvb * NWAVES) {
        const int* te = (const int*)(ws + WS_TOKE) + 2 * t; const float* tw = (const float*)(ws + WS_TOKW) + 2 * t; const int* tp = (const int*)(ws + WS_TOKP) + 2 * t;
        const v4u* src = (const v4u*)((const bf16*)(ws + WS_H2) + (size_t)t * DM) + lane; const v4u a = src[0], c2 = src[64];
#pragma unroll
        for (int s = 0; s < 2; ++s) { const int rs = off[te[s]] + tp[s]; v4u* dst = (v4u*)(XS + (size_t)rs * DM) + lane; dst[0] = a; dst[64] = c2;
            if (lane == 0) { rinfo[rs] = 2 * t + s; roww[rs] = tw[s]; } }
    }
    for (int e = 0; e < NE; ++e) { const int n = off[40 + e], r0 = off[e] + n, r1 = off[e + 1];
        for (int rs = r0 + vb * NWAVES + wave; rs < r1; rs += nvb * NWAVES) { v4u* dst = (v4u*)(XS + (size_t)rs * DM) + lane; const v4u z = {0u, 0u, 0u, 0u}; dst[0] = z; dst[64] = z;
            if (lane == 0) { rinfo[rs] = -1; roww[rs] = 0.f; } } }
}
__device__ __forceinline__ void phase_final(const Params& P, int vb, int nvb) {
    const int tid = threadIdx.x, lane = tid & 63, wave = tid >> 6; unsigned char* ws = P.ws; const float* mod = (const float*)(ws + WS_MOD);
    for (int t = vb * NWAVES + wave; t < T; t += nvb * NWAVES) {
        const int b = t >> 12;
        f32x4* xr = (f32x4*)(P.out + (size_t)t * DM) + lane;
        const v2u* y0 = (const v2u*)((const bf16*)(ws + WS_Y) + (size_t)(2 * t) * DM) + lane; const v2u* y1 = y0 + DM / 4;
        f32x4 v[4]; float s = 0.f;
#pragma unroll
        for (int j = 0; j < 4; ++j) { const int d = 4 * lane + 256 * j; const f32x4 g2 = *(const f32x4*)(mod + b * 6144 + 5120 + d); const v2u a = y0[64 * j], c2 = y1[64 * j];
            v[j] = xr[64 * j];
            v[j].x += g2.x * (bflo(a.x) + bflo(c2.x)); v[j].y += g2.y * (bfhi(a.x) + bfhi(c2.x)); v[j].z += g2.z * (bflo(a.y) + bflo(c2.y)); v[j].w += g2.w * (bfhi(a.y) + bfhi(c2.y));
            s += (v[j].x * v[j].x + v[j].y * v[j].y) + (v[j].z * v[j].z + v[j].w * v[j].w); }
        const float rstd = rsqrtf(wave_sum(s) * (1.f / DM) + EPS);
#pragma unroll
        for (int j = 0; j < 4; ++j) { const f32x4 fw = *(const f32x4*)(P.final_norm_w + 4 * lane + 256 * j);
            xr[64 * j] = (f32x4){v[j].x * rstd * fw.x, v[j].y * rstd * fw.y, v[j].z * rstd * fw.z, v[j].w * rstd * fw.w}; }
    }
}


#define XB_TMO      128
#define XB_XCNT(j)  (256  + 64 * (j))
#define XB_XSUB(j)  (1280 + 64 * (j))
#define XB_XGEN(j)  (2304 + 64 * (j))
#define XB_TOP      3328
#define XB_TOPGEN   3392
#define XCD_BAR_WORDS 3456
#define XB_SPIN_CAP (1u << 18)

__device__ __forceinline__ unsigned xb_ld(unsigned* p)              { return __hip_atomic_load(p, __ATOMIC_RELAXED, __HIP_MEMORY_SCOPE_AGENT); }
__device__ __forceinline__ unsigned xb_add(unsigned* p, unsigned v) { return __hip_atomic_fetch_add(p, v, __ATOMIC_RELAXED, __HIP_MEMORY_SCOPE_AGENT); }
__device__ __forceinline__ unsigned xb_xcc_id() { return (unsigned)__builtin_amdgcn_s_getreg((3 << 11) | 20) & 0xFu; }
#define XB_SPIN(cond, bar) do { unsigned _sp = 0; while (cond) { __builtin_amdgcn_s_sleep(1); \
    if ((++_sp & 255u) == 0u) { if (xb_ld(&(bar)[XB_TMO])) break; if (_sp > XB_SPIN_CAP) { atomicAdd(&(bar)[XB_TMO], 1u); break; } } } } while (0)

struct XcdBarrier {
    unsigned* bar; unsigned x;
    volatile LAS unsigned* st;
};

__device__ __forceinline__ XcdBarrier xcd_barrier_post(unsigned* bar, volatile LAS unsigned* st) {
    XcdBarrier b; b.bar = bar; b.x = xb_xcc_id(); b.st = st;
    if (threadIdx.x == 0) (void)xb_add(&bar[XB_XCNT(b.x)], 1u);
    return b;
}
__device__ __forceinline__ void xcd_barrier_complete(unsigned* bar, unsigned x, unsigned& nloc, unsigned& nx) {
    const unsigned G = gridDim.x * gridDim.y * gridDim.z;
    unsigned sum, cnt, mine, sp = 0u;
    for (;;) {
        sum = 0u; cnt = 0u; mine = 0u;
#pragma unroll
        for (unsigned j = 0; j < 16; ++j) { const unsigned c = xb_ld(&bar[XB_XCNT(j)]); sum += c; cnt += (c > 0u) ? 1u : 0u; mine = (j == x) ? c : mine; }
        if (sum == G) break;
        __builtin_amdgcn_s_sleep(1);
        if ((++sp & 255u) == 0u) { if (xb_ld(&bar[XB_TMO])) break; if (sp > XB_SPIN_CAP) { atomicAdd(&bar[XB_TMO], 1u); break; } }
    }
    nloc = mine > 0u ? mine : 1u; nx = cnt > 0u ? cnt : 1u;
}

__device__ __forceinline__ void xcd_barrier(const XcdBarrier& b) {
    asm volatile("s_waitcnt vmcnt(0)" ::: "memory");
    __syncthreads();
    if (threadIdx.x == 0) {
        unsigned* bar = b.bar;
        __builtin_amdgcn_s_waitcnt(0);
        unsigned nloc = b.st[0], nx = b.st[1];
        if (nloc == 0u) { xcd_barrier_complete(bar, b.x, nloc, nx); b.st[0] = nloc; b.st[1] = nx; }
        const unsigned old = xb_add(&bar[XB_XSUB(b.x)], 1u);
        const unsigned gen = old / nloc;
        if (old + 1u == (gen + 1u) * nloc) {
            __builtin_amdgcn_fence(__ATOMIC_RELEASE, "agent");
            asm volatile("s_waitcnt vmcnt(0)" ::: "memory");
            const unsigned og = xb_add(&bar[XB_TOP], 1u);
            const unsigned tg = og / nx;
            if (og + 1u == (tg + 1u) * nx) xb_add(&bar[XB_TOPGEN], 1u);
            else XB_SPIN(xb_ld(&bar[XB_TOPGEN]) == tg, bar);
            __builtin_amdgcn_fence(__ATOMIC_ACQUIRE, "agent");
            xb_add(&bar[XB_XGEN(b.x)], 1u);
            asm volatile("s_waitcnt vmcnt(0)" ::: "memory");
        } else {
            XB_SPIN(xb_ld(&bar[XB_XGEN(b.x)]) == gen, bar);
            __builtin_amdgcn_fence(__ATOMIC_ACQUIRE, "agent");
            asm volatile("s_waitcnt vmcnt(0)" ::: "memory");
        }
    }
    __syncthreads();
}

enum { PH_PREP = 0, PH_FOLD, PH_GEMM1, PH_MIX_A, PH_MIX_B, PH_MIX_C, PH_OUTPROJ, PH_ROUTE, PH_SCATTER, PH_GATEUP, PH_DOWN, PH_FINAL, PH_COUNT };

template <int PH> __device__ __forceinline__ void run_phase(const Params& P, LAS unsigned char* lds, int vb, int bx, int G) {
    if constexpr (PH == PH_PREP) phase_prep(P, lds, vb, G);
    else if constexpr (PH == PH_FOLD) phase_fold(P, lds, vb, G);
    else if constexpr (PH == PH_GEMM1) phase_gemm1(P, lds, bx, G);
    else if constexpr (PH == PH_MIX_A) phase_mix_a(P, lds, vb, G);
    else if constexpr (PH == PH_MIX_B) phase_mix_b(P, lds, vb, G);
    else if constexpr (PH == PH_MIX_C) phase_mix_c(P, lds, vb, G);
    else if constexpr (PH == PH_OUTPROJ) phase_outproj(P, lds, bx, G);
    else if constexpr (PH == PH_ROUTE) phase_route(P, lds, vb, G);
    else if constexpr (PH == PH_SCATTER) phase_scatter(P, lds, vb, G);
    else if constexpr (PH == PH_GATEUP) phase_gateup(P, lds, bx, G);
    else if constexpr (PH == PH_DOWN) phase_down(P, lds, bx, G);
    else if constexpr (PH == PH_FINAL) phase_final(P, vb, G);
}
#define VB_OF(G, bx) (((G) % 8 == 0) ? ((bx) % 8) * ((G) / 8) + (bx) / 8 : (bx))
#if ONE_LAUNCH
#ifndef REPEAT_MASK
#define REPEAT_MASK 0
#endif
#ifndef N_CG_SYNC
#define N_CG_SYNC 1
#endif
__global__ void __launch_bounds__(NTHR, 2) hymba_fwd(Params P) {
    extern __shared__ __attribute__((aligned(16))) unsigned char lds_raw[];
    LAS unsigned char* lds = (LAS unsigned char*)lds_raw;
    const int G = gridDim.x, bx = blockIdx.x, vb = VB_OF(G, bx);
    cg::grid_group grid = cg::this_grid();
    LAS unsigned* lctl = (LAS unsigned*)(lds + LDS_CTL_OFF);
    if (threadIdx.x < 64) lctl[threadIdx.x] = 0u;
    __syncthreads();
    (void)xcd_barrier_post((unsigned*)(P.ws + WS_CTL) + CW_BAR, (volatile LAS unsigned*)lctl);
#define XBAR() do { XcdBarrier b_; b_.bar = (unsigned*)(P.ws + WS_CTL) + CW_BAR; b_.x = xb_xcc_id(); b_.st = (volatile LAS unsigned*)(lds + LDS_CTL_OFF); xcd_barrier(b_); } while (0)
#define RUN(PH) do { if constexpr ((PHASE_MASK >> PH) & 1) run_phase<PH>(P, lds, vb, bx, G); \
        if constexpr ((REPEAT_MASK >> PH) & 1) { XBAR(); run_phase<PH>(P, lds, vb, bx, G); } \
        if (PH + 1 < PH_COUNT) { if (PH < N_CG_SYNC) grid.sync(); else { XcdBarrier b_; b_.bar = (unsigned*)(P.ws + WS_CTL) + CW_BAR; b_.x = xb_xcc_id(); b_.st = (volatile LAS unsigned*)(lds + LDS_CTL_OFF); xcd_barrier(b_); } } } while (0)
    RUN(0); RUN(1); RUN(2); RUN(3); RUN(4); RUN(5); RUN(6); RUN(7); RUN(8); RUN(9); RUN(10); RUN(11);
#undef RUN
}
#else
template <int PH> __global__ void __launch_bounds__(NTHR, 2) k_phase(Params P) {
    extern __shared__ __attribute__((aligned(16))) unsigned char lds_raw[];
    LAS unsigned char* lds = (LAS unsigned char*)lds_raw;
    const int G = gridDim.x, bx = blockIdx.x, vb = VB_OF(G, bx);
    run_phase<PH>(P, lds, vb, bx, G);
}
template <int PH> static bool launch_phase(const Params& p, int grid, hipStream_t stream) {
    static bool attr = false;
    if (!attr) { if (hipFuncSetAttribute((const void*)k_phase<PH>, hipFuncAttributeMaxDynamicSharedMemorySize, LDS_BYTES) != hipSuccess) { fprintf(stderr, "hipFuncSetAttribute failed (phase %d)\n", PH); return false; } attr = true; }
    hipLaunchKernelGGL(k_phase<PH>, dim3(grid), dim3(NTHR), LDS_BYTES, stream, p);
    return true;
}
#endif

extern "C" void kernel_launch(void* const* d_in, const int* in_sizes, int n_in, void* d_out, int out_size, void* d_ws, size_t ws_size, hipStream_t stream) {
    static int grid = 0;
    if (grid == 0) {
        if (n_in != 24 || out_size != T * DM || ws_size < WS_END) { fprintf(stderr, "kernel_launch: unexpected shapes (n_in %d out %d ws %zu)\n", n_in, out_size, ws_size); grid = -1; return; }
        int dev = 0, cus = 0;
        if (hipGetDevice(&dev) != hipSuccess || hipDeviceGetAttribute(&cus, hipDeviceAttributeMultiprocessorCount, dev) != hipSuccess) { grid = -1; return; }
#if ONE_LAUNCH
        int per_cu = 0;
        if (hipFuncSetAttribute((const void*)hymba_fwd, hipFuncAttributeMaxDynamicSharedMemorySize, LDS_BYTES) != hipSuccess) { fprintf(stderr, "kernel_launch: hipFuncSetAttribute failed\n"); grid = -1; return; }
        if (hipOccupancyMaxActiveBlocksPerMultiprocessor(&per_cu, (const void*)hymba_fwd, NTHR, LDS_BYTES) != hipSuccess || per_cu < 1) { fprintf(stderr, "kernel_launch: occupancy query says %d blocks per CU\n", per_cu); grid = -1; return; }
#endif
        grid = cus;
        (void)hipGetLastError();
    }
    if (grid < 0) return;
    (void)hipMemsetAsync((char*)d_ws + WS_CTL, 0, CTL_ZERO_BYTES, stream);
    Params p{};
    p.x = (const float*)d_in[0]; p.c = (const float*)d_in[1]; p.positions = (const int*)d_in[2]; p.norm1_w = (const float*)d_in[3]; p.norm2_w = (const float*)d_in[4];
    p.final_norm_w = (const float*)d_in[5]; p.ada_w = (const float*)d_in[6]; p.ada_b = (const float*)d_in[7]; p.w_in = (const float*)d_in[8]; p.w_out = (const float*)d_in[9];
    p.lq1 = (const float*)d_in[10]; p.lk1 = (const float*)d_in[11]; p.lq2 = (const float*)d_in[12]; p.lk2 = (const float*)d_in[13]; p.subln_w = (const float*)d_in[14];
    p.hg_lb = (const float*)d_in[15]; p.hg_norm_w = (const float*)d_in[16]; p.w_group = (const float*)d_in[17]; p.b_group = (const float*)d_in[18];
    p.w_router = (const float*)d_in[19]; p.b_router = (const float*)d_in[20]; p.w_gate = (const float*)d_in[21]; p.w_up = (const float*)d_in[22]; p.w_down = (const float*)d_in[23];
    p.out = (float*)d_out; p.ws = (unsigned char*)d_ws; p.ph_lo = 0; p.ph_hi = PH_COUNT;
#if ONE_LAUNCH
    void* args[] = {&p};
    hipError_t e = hipLaunchCooperativeKernel((const void*)hymba_fwd, dim3(grid), dim3(NTHR), args, LDS_BYTES, stream);
    if (e != hipSuccess) fprintf(stderr, "cooperative launch failed: %s (grid %d)\n", hipGetErrorString(e), grid);
#else
    launch_phase<0>(p, grid, stream); launch_phase<1>(p, grid, stream); launch_phase<2>(p, grid, stream); launch_phase<3>(p, grid, stream);
    launch_phase<4>(p, grid, stream); launch_phase<5>(p, grid, stream); launch_phase<6>(p, grid, stream); launch_phase<7>(p, grid, stream);
    launch_phase<8>(p, grid, stream); launch_phase<9>(p, grid, stream); launch_phase<10>(p, grid, stream); launch_phase<11>(p, grid, stream);
#endif
}
```
